# Optimizing an MI355X kernel written in HIP

```python
import math
import jax, jax.numpy as jnp
from jax import lax
import numpy as np

D_MODEL = 1024
BATCH = 16
SEQ = 2048
DEPTH = 1

CHUNK = 64
N_META = 16
Q_BLOCK = 128
ROPE_THETA = 10000.0
EPS = 1e-6
NEG_INF = -1e30
BIG_ID = 2 ** 30

DIFF_HEADS = 4
DIFF_HEAD_DIM = 64
DIFF_V_DIM = 2 * DIFF_HEAD_DIM
DIFF_QK_WIDTH = DIFF_HEADS * 2 * DIFF_HEAD_DIM
DIFF_WIDTH = DIFF_HEADS * DIFF_V_DIM

FOX_HEADS = 8
FOX_HEAD_DIM = 64
FOX_WIDTH = FOX_HEADS * FOX_HEAD_DIM

DQ_OFF = 0
DK_OFF = DQ_OFF + DIFF_QK_WIDTH
DV_OFF = DK_OFF + DIFF_QK_WIDTH
FQ_OFF = DV_OFF + DIFF_WIDTH
FK_OFF = FQ_OFF + FOX_WIDTH
FV_OFF = FK_OFF + FOX_WIDTH
FF_OFF = FV_OFF + FOX_WIDTH
GA_OFF = FF_OFF + FOX_HEADS
GB_OFF = GA_OFF + D_MODEL
IN_COLS = GB_OFF + D_MODEL

PEER_HEADS = 8
PEER_N_KEYS = 128
PEER_N_EXPERTS = PEER_N_KEYS * PEER_N_KEYS
PEER_KEY_DIM = 256
PEER_HALF = PEER_KEY_DIM // 2
PEER_TOPK = 16
PEER_TOKEN_BLOCK = 256

kernel_name = "hybrid_diff_fox_peer_block"


def _rmsnorm(x, g):
    xf = x.astype(jnp.float32)
    y = xf * lax.rsqrt(jnp.mean(xf * xf, axis=-1, keepdims=True) + EPS)
    return (y * g.astype(jnp.float32)).astype(x.dtype)


def _rope(x, T):
    d = x.shape[-1]
    inv_freq = ROPE_THETA ** (-jnp.arange(0, d, 2, dtype=jnp.float32) / d)
    ang = jnp.arange(T, dtype=jnp.float32)[:, None] * inv_freq[None, :]
    cos = jnp.concatenate([jnp.cos(ang), jnp.cos(ang)], axis=-1)
    sin = jnp.concatenate([jnp.sin(ang), jnp.sin(ang)], axis=-1)
    xf = x.astype(jnp.float32)
    x1, x2 = xf[..., : d // 2], xf[..., d // 2:]
    rot = jnp.concatenate([-x2, x1], axis=-1)
    return (xf * cos + rot * sin).astype(x.dtype)


def _blocked_attention(q, k, v, q_ids, k_ids, log_decay=None):
    B, G, H, T, d = q.shape
    dv = v.shape[-1]
    n_blk = T // Q_BLOCK
    scale = d ** -0.5

    def one_block(i):
        start = i * Q_BLOCK
        qb = lax.dynamic_slice_in_dim(q, start, Q_BLOCK, axis=3)
        s = jnp.einsum("bghqd,bghkd->bghqk", qb, k).astype(jnp.float32) * scale
        if log_decay is not None:
            cq = lax.dynamic_slice_in_dim(log_decay, start, Q_BLOCK, axis=2)
            s = s + (cq[:, None, :, :, None] - log_decay[:, None, :, None, :])
        qi = lax.dynamic_slice_in_dim(q_ids, start, Q_BLOCK, axis=0)
        allowed = k_ids[None, :] <= qi[:, None]
        s = jnp.where(allowed, s, NEG_INF)
        p = jax.nn.softmax(s, axis=-1).astype(v.dtype)
        return jnp.einsum("bghqk,bhkv->bghqv", p, v)

    out = lax.map(one_block, jnp.arange(n_blk))
    out = jnp.transpose(out, (1, 2, 3, 0, 4, 5))
    return out.reshape(B, G, H, T, dv)


def _token_mixer(h, layer, w_in, b_gate, b_forget, diff_qnorm_g, diff_knorm_g,
                 diff_lambda, diff_subln_g, fox_qnorm_g, fox_knorm_g,
                 w_branch_diff, w_branch_fox, w_out, chunk_ids, frame_ids):
    B, T, _ = h.shape
    proj = h @ w_in

    dq = proj[..., DQ_OFF:DK_OFF].reshape(B, T, 2, DIFF_HEADS, DIFF_HEAD_DIM)
    dk = proj[..., DK_OFF:DV_OFF].reshape(B, T, 2, DIFF_HEADS, DIFF_HEAD_DIM)
    dv = proj[..., DV_OFF:FQ_OFF].reshape(B, T, DIFF_HEADS, DIFF_V_DIM)
    dq = _rope(_rmsnorm(jnp.transpose(dq, (0, 2, 3, 1, 4)), diff_qnorm_g), T)
    dk = _rope(_rmsnorm(jnp.transpose(dk, (0, 2, 3, 1, 4)), diff_knorm_g), T)
    dv = jnp.transpose(dv, (0, 2, 1, 3))
    o = _blocked_attention(dq, dk, dv, chunk_ids, chunk_ids)
    lam_init = 0.8 - 0.6 * math.exp(-0.3 * layer)
    lam = diff_lambda.astype(jnp.float32)
    lam = (jnp.exp(jnp.sum(lam[0] * lam[1])) - jnp.exp(jnp.sum(lam[2] * lam[3]))
           + lam_init).astype(o.dtype)
    od = o[:, 0] - lam * o[:, 1]
    od = _rmsnorm(od, diff_subln_g) * (1.0 - lam_init)
    y_a = jnp.transpose(od, (0, 2, 1, 3)).reshape(B, T, DIFF_WIDTH)

    fq = proj[..., FQ_OFF:FK_OFF].reshape(B, T, FOX_HEADS, FOX_HEAD_DIM)
    fk = proj[..., FK_OFF:FV_OFF].reshape(B, T, FOX_HEADS, FOX_HEAD_DIM)
    fv = proj[..., FV_OFF:FF_OFF].reshape(B, T, FOX_HEADS, FOX_HEAD_DIM)
    fq = _rmsnorm(jnp.transpose(fq, (0, 2, 1, 3)), fox_qnorm_g)[:, None]
    fk = _rmsnorm(jnp.transpose(fk, (0, 2, 1, 3)), fox_knorm_g)[:, None]
    fv = jnp.transpose(fv, (0, 2, 1, 3))
    f_logit = (proj[..., FF_OFF:GA_OFF] + b_forget).astype(jnp.float32)
    log_f = jax.nn.log_sigmoid(f_logit)
    cum = jnp.transpose(jnp.cumsum(log_f, axis=1), (0, 2, 1))
    of = _blocked_attention(fq, fk, fv, frame_ids, frame_ids, log_decay=cum)[:, 0]
    y_b = jnp.transpose(of, (0, 2, 1, 3)).reshape(B, T, FOX_WIDTH)

    g_a = jax.nn.sigmoid(proj[..., GA_OFF:GB_OFF] + b_gate[:D_MODEL])
    g_b = jax.nn.sigmoid(proj[..., GB_OFF:IN_COLS] + b_gate[D_MODEL:])
    merged = g_a * (y_a @ w_branch_diff) + g_b * (y_b @ w_branch_fox)
    return merged @ w_out


def _peer(h, w_q, subkeys, u, v):
    B, T, D = h.shape
    n_tok = B * T
    n_pad = -(-n_tok // PEER_TOKEN_BLOCK) * PEER_TOKEN_BLOCK
    flat = jnp.pad(h.reshape(n_tok, D), ((0, n_pad - n_tok), (0, 0)))
    blocks = flat.reshape(n_pad // PEER_TOKEN_BLOCK, PEER_TOKEN_BLOCK, D)
    BLK = PEER_TOKEN_BLOCK

    def one_block(xb):
        q = (xb @ w_q).reshape(BLK, PEER_HEADS, 2, PEER_HALF)
        s = jnp.einsum("nhcd,hckd->nhck", q, subkeys).astype(jnp.float32)
        s1, i1 = lax.top_k(s[:, :, 0], PEER_TOPK)
        s2, i2 = lax.top_k(s[:, :, 1], PEER_TOPK)
        cand = (s1[..., :, None] + s2[..., None, :]).reshape(BLK, PEER_HEADS, PEER_TOPK * PEER_TOPK)
        cidx = (i1[..., :, None] * PEER_N_KEYS + i2[..., None, :]).reshape(BLK, PEER_HEADS, PEER_TOPK * PEER_TOPK)
        best, pos = lax.top_k(cand, PEER_TOPK)
        eidx = jnp.take_along_axis(cidx, pos, axis=-1).reshape(BLK, PEER_HEADS * PEER_TOPK)
        gate = jax.nn.softmax(best, axis=-1).reshape(BLK, PEER_HEADS * PEER_TOPK)
        ue = jnp.take(u, eidx, axis=0)
        act = jax.nn.gelu(jnp.einsum("nd,ned->ne", xb, ue), approximate=False)
        ve = jnp.take(v, eidx, axis=0)
        w = gate.astype(xb.dtype) * act
        return jnp.einsum("ne,ned->nd", w, ve)

    y = lax.map(one_block, blocks).reshape(n_pad, D)[:n_tok]
    return y.reshape(B, T, D)


def setup_inputs(seed: int = 0) -> dict:
    key = jax.random.key(seed)
    ks = jax.random.split(key, 20)
    f32 = jnp.float32
    nrm = lambda k, shape, s: jax.random.normal(k, shape, f32) * s
    gain = lambda k, shape: 1.0 + 0.05 * jax.random.normal(k, shape, f32)
    return {
        "x": jax.random.normal(ks[0], (BATCH, SEQ, D_MODEL), f32),
        "meta_tokens": nrm(ks[1], (N_META, D_MODEL), 1.0),
        "norm_mix_g": gain(ks[2], (DEPTH, D_MODEL)),
        "w_in": nrm(ks[3], (DEPTH, D_MODEL, IN_COLS), D_MODEL ** -0.5),
        "b_gate": nrm(ks[4], (DEPTH, 2 * D_MODEL), 0.02),
        "b_forget": 3.0 + nrm(ks[5], (DEPTH, FOX_HEADS), 0.1),
        "diff_qnorm_g": gain(ks[6], (DEPTH, DIFF_HEAD_DIM)),
        "diff_knorm_g": gain(ks[7], (DEPTH, DIFF_HEAD_DIM)),
        "diff_lambda": nrm(ks[8], (DEPTH, 4, DIFF_HEAD_DIM), 0.1),
        "diff_subln_g": gain(ks[9], (DEPTH, DIFF_V_DIM)),
        "fox_qnorm_g": gain(ks[10], (DEPTH, FOX_HEAD_DIM)),
        "fox_knorm_g": gain(ks[11], (DEPTH, FOX_HEAD_DIM)),
        "w_branch_diff": nrm(ks[12], (DEPTH, DIFF_WIDTH, D_MODEL), DIFF_WIDTH ** -0.5),
        "w_branch_fox": nrm(ks[13], (DEPTH, FOX_WIDTH, D_MODEL), FOX_WIDTH ** -0.5),
        "w_out": nrm(ks[14], (DEPTH, D_MODEL, D_MODEL), D_MODEL ** -0.5),
        "norm_ffn_g": gain(ks[15], (DEPTH, D_MODEL)),
        "peer_w_q": nrm(ks[16], (DEPTH, D_MODEL, PEER_HEADS * PEER_KEY_DIM), D_MODEL ** -0.5),
        "peer_subkeys": nrm(ks[17], (DEPTH, PEER_HEADS, 2, PEER_N_KEYS, PEER_HALF), PEER_HALF ** -0.5),
        "peer_u": nrm(ks[18], (DEPTH, PEER_N_EXPERTS, D_MODEL), D_MODEL ** -0.5),
        "peer_v": nrm(ks[19], (DEPTH, PEER_N_EXPERTS, D_MODEL), 0.5),
    }


def reference(x, meta_tokens, norm_mix_g, w_in, b_gate, b_forget, diff_qnorm_g,
              diff_knorm_g, diff_lambda, diff_subln_g, fox_qnorm_g, fox_knorm_g,
              w_branch_diff, w_branch_fox, w_out, norm_ffn_g, peer_w_q,
              peer_subkeys, peer_u, peer_v):
    B, S, D = x.shape
    T_ext = S + N_META
    T_pad = -(-T_ext // Q_BLOCK) * Q_BLOCK

    meta = jnp.broadcast_to(meta_tokens.astype(x.dtype)[None], (B, N_META, D))
    hstream = jnp.concatenate([meta, x], axis=1)

    pos = jnp.arange(T_pad, dtype=jnp.int32)
    chunk_ids = jnp.where(pos < N_META, 0, 1 + (pos - N_META) // CHUNK)
    chunk_ids = jnp.where(pos < T_ext, chunk_ids, BIG_ID).astype(jnp.int32)
    frame_ids = pos

    for layer in range(DEPTH):
        h = _rmsnorm(hstream, norm_mix_g[layer])
        h = jnp.pad(h, ((0, 0), (0, T_pad - T_ext), (0, 0)))
        mix = _token_mixer(h, layer, w_in[layer], b_gate[layer], b_forget[layer],
                           diff_qnorm_g[layer], diff_knorm_g[layer], diff_lambda[layer],
                           diff_subln_g[layer], fox_qnorm_g[layer], fox_knorm_g[layer],
                           w_branch_diff[layer], w_branch_fox[layer], w_out[layer],
                           chunk_ids, frame_ids)
        hstream = hstream + mix[:, :T_ext]
        h2 = _rmsnorm(hstream, norm_ffn_g[layer])
        hstream = hstream + _peer(h2, peer_w_q[layer], peer_subkeys[layer],
                                  peer_u[layer], peer_v[layer])

    return hstream[:, N_META:]
```

```cpp
#include <hip/hip_runtime.h>
#include <hip/hip_bf16.h>
#include <cstdio>
#include <cstdint>
#include <cmath>
#ifndef DUPMASK
#define DUPMASK 0
#endif
constexpr size_t MiB = 1u << 20;
constexpr size_t WS_CTL = 0, CTL_ZERO_BYTES = 1 * MiB;
constexpr size_t WS_LOGFM = 1 * MiB;
constexpr size_t WS_GAINS = 1 * MiB + 4096;
constexpr size_t WS_WIN = 2 * MiB, WS_WBD = 12 * MiB, WS_WBF = 13 * MiB, WS_WOUT = 14 * MiB, WS_WQ = 16 * MiB, WS_SK = 20 * MiB;
constexpr size_t WS_CB = 21 * MiB;
constexpr size_t WS_LOGF = 23 * MiB;
constexpr size_t WS_US8 = 24 * MiB, WS_VS8 = 40 * MiB, WS_W = 56 * MiB;
constexpr size_t WS_XB = 88 * MiB;
constexpr size_t WS_DQ = 152 * MiB, WS_DK = 184 * MiB, WS_DV = 217 * MiB, WS_FQ = 250 * MiB, WS_FK = 282 * MiB, WS_FV = 315 * MiB;
constexpr size_t WS_GA = 348 * MiB, WS_GB = 412 * MiB, WS_OF = 476 * MiB, WS_SSQP = 508 * MiB, WS_END = 510 * MiB;
constexpr size_t WS_OD = WS_XB, WS_YA = 56 * MiB  , WS_TMP = WS_FQ, WS_MERGED = WS_DK, WS_H1B = WS_XB, WS_Q2 = WS_GA, WS_EIDX = 250 * MiB, WS_GATE = 258 * MiB, WS_PD = WS_GA;
constexpr int CW_TMO = 0;
constexpr int CW_BAR = 4096;

__device__ __forceinline__ int mk_lane() { return (int)__builtin_amdgcn_mbcnt_hi(~0u, __builtin_amdgcn_mbcnt_lo(~0u, 0u)); }
__device__ __forceinline__ int mk_lane_v() { int l; asm volatile("v_mbcnt_lo_u32_b32 %0, -1, 0\n\tv_mbcnt_hi_u32_b32 %0, -1, %0" : "=v"(l)); return l; }
namespace pg8 {
#define PG8_LAS __attribute__((address_space(3)))
typedef unsigned short bf16_t;
typedef short bf16x8 __attribute__((ext_vector_type(8)));
typedef float f32x4 __attribute__((ext_vector_type(4)));
typedef unsigned u32x4 __attribute__((ext_vector_type(4)));
constexpr int BM = 256, BK = 64, HALF = 128, HTB = HALF * BK * 2  , STAGE_BYTES = 8 * HTB, NXCD = 8, WGM = 8;

__host__ __device__ __forceinline__ int lds_byte(int r, int c) { const int st = (r >> 4) * 2 + (c >> 5), rr = r & 15, cc = c & 31, ob = rr * 64 + cc * 2; return st * 1024 + (ob ^ (((ob >> 9) & 1) << 5)); }
__host__ __device__ __forceinline__ void stage_rc(int b, int& R, int& C) { const int st = b / 1024, sb = b % 1024, swz = sb ^ (((sb >> 9) & 1) << 5); R = (st >> 1) * 16 + swz / 64; C = (st & 1) * 32 + (swz % 64) / 2; }
__host__ __device__ __forceinline__ int perm32(int rho) { const int n = rho >> 4, i = rho & 15; return 8 * (i >> 2) + 4 * n + (i & 3); }

struct Unit { int pm, pn; };
struct Gemm { const bf16_t* A; const bf16_t* Bt; int M, N, K; };

struct StaticOrder {
    int nM, nN, nwg, G, c;
    __host__ __device__ void init(int M, int N, int G_, int c_) { nM = M / BM; nN = N / BM; nwg = nM * nN; G = G_; c = c_; }
    __host__ __device__ bool next(int i, Unit& u) const {
        const long L = (long)i * G + c; if (L >= nwg) return false;
        int wgid = (int)L; { const int q = nwg / NXCD, r = nwg % NXCD, xcd = wgid % NXCD, off = wgid / NXCD; wgid = (xcd < r ? xcd * (q + 1) : r * (q + 1) + (xcd - r) * q) + off; }
        const int nig = WGM * nN, gid = wgid / nig, fm = gid * WGM, gsz = (nM - fm) < WGM ? (nM - fm) : WGM;
        u.pm = fm + ((wgid % nig) % gsz); u.pn = (wgid % nig) / gsz; return true;
    }
    __device__ __forceinline__ void a_ready(const Unit&) const {}
    __device__ __forceinline__ void done(const Unit&) const {}
};

typedef float f32x2_cv __attribute__((ext_vector_type(2))); typedef __bf16 bf16x2_cv __attribute__((ext_vector_type(2)));
__device__ __forceinline__ unsigned cvt_pk_bf16(float lo, float hi) { f32x2_cv v = {lo, hi}; bf16x2_cv b = __builtin_convertvector(v, bf16x2_cv); return __builtin_bit_cast(unsigned, b); }
__device__ __forceinline__ float bf_lo(unsigned w) { return __uint_as_float(w << 16); }
__device__ __forceinline__ float bf_hi(unsigned w) { return __uint_as_float(w & 0xffff0000u); }
__device__ __forceinline__ unsigned cvt_pk4_fp8(float a, float b, float c, float d) { int p = __builtin_amdgcn_cvt_pk_fp8_f32(a, b, 0, false); p = __builtin_amdgcn_cvt_pk_fp8_f32(c, d, p, true); return (unsigned)p; }
typedef unsigned u32x2 __attribute__((ext_vector_type(2)));
constexpr float C2F = 0.125f * 1.4426950408889634f;
constexpr int KROWS = 2112;

__device__ __forceinline__ u32x4 dpp_ror8(const u32x4 v) {
    u32x4 r; r.x = (unsigned)__builtin_amdgcn_update_dpp(0, (int)v.x, 0x128, 0xf, 0xf, true); r.y = (unsigned)__builtin_amdgcn_update_dpp(0, (int)v.y, 0x128, 0xf, 0xf, true);
    r.z = (unsigned)__builtin_amdgcn_update_dpp(0, (int)v.z, 0x128, 0xf, 0xf, true); r.w = (unsigned)__builtin_amdgcn_update_dpp(0, (int)v.w, 0x128, 0xf, 0xf, true); return r;
}
__device__ __forceinline__ void xchg_rows(const u32x4 d0, const u32x4 d1, bool lo, u32x4& w1, u32x4& w2) {
    u32x4 snd; snd.x = lo ? d1.x : d0.x; snd.y = lo ? d1.y : d0.y; snd.z = lo ? d1.z : d0.z; snd.w = lo ? d1.w : d0.w;
    const u32x4 rcv = dpp_ror8(snd);
    w1.x = lo ? d0.x : rcv.x; w1.y = lo ? d0.y : rcv.y; w1.z = lo ? d0.z : rcv.z; w1.w = lo ? d0.w : rcv.w;
    w2.x = lo ? rcv.x : d1.x; w2.y = lo ? rcv.y : d1.y; w2.z = lo ? rcv.z : d1.z; w2.w = lo ? rcv.w : d1.w;
}
__device__ __forceinline__ void xchg_rows2(const u32x2 d0, const u32x2 d1, bool lo, u32x2& w1, u32x2& w2) {
    u32x2 snd; snd.x = lo ? d1.x : d0.x; snd.y = lo ? d1.y : d0.y;
    u32x2 rcv; rcv.x = (unsigned)__builtin_amdgcn_update_dpp(0, (int)snd.x, 0x128, 0xf, 0xf, true); rcv.y = (unsigned)__builtin_amdgcn_update_dpp(0, (int)snd.y, 0x128, 0xf, 0xf, true);
    w1.x = lo ? d0.x : rcv.x; w1.y = lo ? d0.y : rcv.y; w2.x = lo ? rcv.x : d1.x; w2.y = lo ? rcv.y : d1.y;
}
struct EpiProj {
    static constexpr bool PERM = true, AFTER_DRAIN = false;
    unsigned char* ws;
    const PG8_LAS float* gains;
    const PG8_LAS float* bgate;
    float dsc;
    __device__ __forceinline__ void operator()(const f32x4 (&acc)[2][2][4][2], const Unit& u, int wr, int wc, int fr_in, int fq_in) const {
        int fr = fr_in, fq = fq_in; asm volatile("" : "+v"(fr), "+v"(fq));
        const int pn = u.pn;
        const bool lo = fr < 8;
        const int rowt = u.pm * BM + wr * 64 + fr;
        if (pn < 4 || (pn >= 6 && pn < 10)) {
            const bool isdiff = pn < 4;
            const bool isq = isdiff ? (pn < 2) : (pn < 8);
            const PG8_LAS float* gain = gains + (isdiff ? (isq ? 0 : 64) : (isq ? 128 : 192));
            bf16_t* outp = (bf16_t*)(ws + (isdiff ? (isq ? WS_DQ : WS_DK) : (isq ? WS_FQ : WS_FK)));
            const float osc = isq ? C2F : 1.0f;
            f32x4 gv[2][2];
#pragma unroll
            for (int bj = 0; bj < 2; ++bj)
#pragma unroll
                for (int n = 0; n < 2; ++n) gv[bj][n] = *(const PG8_LAS f32x4*)(gain + 32 * bj + 8 * fq + 4 * n);
            float rf[2][4];
#pragma unroll
            for (int n = 0; n < 2; ++n)
#pragma unroll
                for (int e = 0; e < 4; ++e) { const int i = 8 * fq + 4 * n + e; rf[n][e] = __builtin_amdgcn_exp2f(-(float)i * (13.287712379549449f / 32.0f)) * 0.15915494309189535f; }
            const int colb = (pn & 1) * 256 + 64 * wc + 8 * fq;
#pragma unroll
            for (int ai = 0; ai < 2; ++ai)
#pragma unroll
                for (int m = 0; m < 4; ++m) {
                    const int row = rowt + ai * HALF + m * 16;
                    const int itok = row & 2047;
                    const size_t orow = isq ? (size_t)row : (size_t)(row >> 11) * KROWS + itok;
                    float ss = 0.f;
#pragma unroll
                    for (int bj = 0; bj < 2; ++bj)
#pragma unroll
                        for (int n = 0; n < 2; ++n) { const f32x4 x = acc[ai][bj][m][n]; ss += (x[0] * x[0] + x[1] * x[1]) + (x[2] * x[2] + x[3] * x[3]); }
                    ss += __shfl_xor(ss, 16); ss += __shfl_xor(ss, 32);
                    const float rs = __builtin_amdgcn_rsqf(ss * (dsc * dsc * (1.0f / 64.0f)) + 1e-6f) * osc * dsc;
                    f32x4 y[2][2];
#pragma unroll
                    for (int bj = 0; bj < 2; ++bj)
#pragma unroll
                        for (int n = 0; n < 2; ++n) y[bj][n] = acc[ai][bj][m][n] * gv[bj][n] * rs;
                    if (isdiff) {
                        const float pos = (float)(16 + itok);
#pragma unroll
                        for (int n = 0; n < 2; ++n)
#pragma unroll
                            for (int e = 0; e < 4; ++e) {
                                float rev = pos * rf[n][e]; rev = __builtin_amdgcn_fractf(rev);
                                const float c = __builtin_amdgcn_cosf(rev), s = __builtin_amdgcn_sinf(rev);
                                const float x1 = y[0][n][e], x2 = y[1][n][e];
                                y[0][n][e] = x1 * c - x2 * s; y[1][n][e] = x2 * c + x1 * s;
                            }
                    }
                    u32x4 d[2];
#pragma unroll
                    for (int bj = 0; bj < 2; ++bj) { d[bj].x = cvt_pk_bf16(y[bj][0][0], y[bj][0][1]); d[bj].y = cvt_pk_bf16(y[bj][0][2], y[bj][0][3]); d[bj].z = cvt_pk_bf16(y[bj][1][0], y[bj][1][1]); d[bj].w = cvt_pk_bf16(y[bj][1][2], y[bj][1][3]); }
                    u32x4 w1, w2; xchg_rows(d[0], d[1], lo, w1, w2);
                    const size_t os = (orow - (size_t)(fr & 8) + (size_t)0) * 512 + colb + (lo ? 0 : 32);
                    *(u32x4*)(outp + os) = w1;
                    *(u32x4*)(outp + os + 8 * 512) = w2;
                }
        } else if (pn < 12) {
            bf16_t* outp = (bf16_t*)(ws + (pn < 6 ? WS_DV : WS_FV));
            const int colb = (pn & 1) * 256 + 64 * wc + 8 * fq + (lo ? 0 : 32);
#pragma unroll
            for (int ai = 0; ai < 2; ++ai)
#pragma unroll
                for (int m = 0; m < 4; ++m) {
                    const int row = rowt - (fr & 8) + ai * HALF + m * 16;
                    const size_t orow = (size_t)(row >> 11) * KROWS + (row & 2047);
                    u32x4 d[2];
#pragma unroll
                    for (int bj = 0; bj < 2; ++bj) {
                        const f32x4 v0 = acc[ai][bj][m][0] * dsc, v1 = acc[ai][bj][m][1] * dsc;
                        d[bj].x = cvt_pk_bf16(v0[0], v0[1]); d[bj].y = cvt_pk_bf16(v0[2], v0[3]); d[bj].z = cvt_pk_bf16(v1[0], v1[1]); d[bj].w = cvt_pk_bf16(v1[2], v1[3]);
                    }
                    u32x4 w1, w2; xchg_rows(d[0], d[1], lo, w1, w2);
                    *(u32x4*)(outp + orow * 512 + colb) = w1;
                    *(u32x4*)(outp + (orow + 8) * 512 + colb) = w2;
                }
        } else {
            const bool isb = pn >= 16;
            unsigned char* outp = ws + (isb ? WS_GB : WS_GA);
            const int colb = ((pn - 12) & 3) * 256 + 64 * wc + 8 * fq;
            const PG8_LAS float* bp = bgate + (isb ? 1024 : 0) + colb;
            f32x4 bv[2][2];
#pragma unroll
            for (int bj = 0; bj < 2; ++bj)
#pragma unroll
                for (int n = 0; n < 2; ++n) bv[bj][n] = *(const PG8_LAS f32x4*)(bp + 32 * bj + 4 * n) * -1.4426950408889634f;
            const float nds = -1.4426950408889634f * dsc;
#pragma unroll
            for (int ai = 0; ai < 2; ++ai)
#pragma unroll
                for (int m = 0; m < 4; ++m) {
                    const size_t row = (size_t)(rowt - (fr & 8) + ai * HALF + m * 16);
                    u32x2 d[2];
#pragma unroll
                    for (int bj = 0; bj < 2; ++bj) {
                        f32x4 v0 = acc[ai][bj][m][0] * nds + bv[bj][0], v1 = acc[ai][bj][m][1] * nds + bv[bj][1];
#pragma unroll
                        for (int e = 0; e < 4; ++e) { v0[e] = __builtin_rintf(__builtin_amdgcn_rcpf(__builtin_fmaf(__builtin_amdgcn_exp2f(v0[e]), 1.0f / 255.0f, 1.0f / 255.0f))); v1[e] = __builtin_rintf(__builtin_amdgcn_rcpf(__builtin_fmaf(__builtin_amdgcn_exp2f(v1[e]), 1.0f / 255.0f, 1.0f / 255.0f))); }
                        u32x2 w; unsigned p0 = 0u, p1 = 0u;
                        p0 = __builtin_amdgcn_cvt_pk_u8_f32(v0[0], 0, p0); p0 = __builtin_amdgcn_cvt_pk_u8_f32(v0[1], 1, p0); p0 = __builtin_amdgcn_cvt_pk_u8_f32(v0[2], 2, p0); p0 = __builtin_amdgcn_cvt_pk_u8_f32(v0[3], 3, p0);
                        p1 = __builtin_amdgcn_cvt_pk_u8_f32(v1[0], 0, p1); p1 = __builtin_amdgcn_cvt_pk_u8_f32(v1[1], 1, p1); p1 = __builtin_amdgcn_cvt_pk_u8_f32(v1[2], 2, p1); p1 = __builtin_amdgcn_cvt_pk_u8_f32(v1[3], 3, p1);
                        w.x = p0; w.y = p1; d[bj] = w;
                    }
                    u32x2 w1, w2; xchg_rows2(d[0], d[1], lo, w1, w2);
                    *(u32x2*)(outp + row * 1024 + colb + (lo ? 0 : 32)) = w1;
                    *(u32x2*)(outp + (row + 8) * 1024 + colb + (lo ? 0 : 32)) = w2;
                }
        }
    }
};

template <bool SECOND> struct EpiGateT {
    static constexpr bool PERM = true, AFTER_DRAIN = false;
    static constexpr float sc8 = 32.0f, dsc = 1.0f / (16.0f * 256.0f);
    unsigned char* ws;
    __device__ __forceinline__ void operator()(const f32x4 (&acc)[2][2][4][2], const Unit& u, int wr, int wc, int fr_in, int fq_in) const {
        int fr = fr_in, fq = fq_in; asm volatile("" : "+v"(fr), "+v"(fq));
        const unsigned char* gate = ws + (SECOND ? WS_GB : WS_GA); const bf16_t* prev = (const bf16_t*)(ws + WS_TMP); bf16_t* out = (bf16_t*)(ws + WS_TMP); unsigned char* out8 = SECOND ? ws + WS_MERGED : nullptr;
        const int rowt = u.pm * BM + wr * 64 + fr, colb = u.pn * BM + 32 * wc + 8 * fq;
        constexpr bool hp = SECOND;
        u32x2 gc[2], gn[2]; u32x4 pc[2], pn_[2];
#define EG_OFF(s) ((size_t)(rowt + ((s) >> 2) * HALF + ((s) & 3) * 16) * 1024 + colb)
#define EG_LOAD(G, P, s) do { const size_t o_ = EG_OFF(s); G[0] = *(const u32x2*)(gate + o_); G[1] = *(const u32x2*)(gate + o_ + HALF); if (hp) { P[0] = *(const u32x4*)(prev + o_); P[1] = *(const u32x4*)(prev + o_ + HALF); } } while (0)
        EG_LOAD(gc, pc, 0);
#pragma unroll
        for (int s = 0; s < 8; ++s) {
            if (s < 7) EG_LOAD(gn, pn_, s + 1);
            const int ai = s >> 2, m = s & 3; const size_t off = EG_OFF(s);
#pragma unroll
            for (int bj = 0; bj < 2; ++bj) {
                const u32x2 g = gc[bj]; const unsigned g0 = g.x, g1 = g.y;
                const f32x4 a0 = acc[ai][bj][m][0], a1 = acc[ai][bj][m][1];
                constexpr float dg = dsc * (1.0f / 255.0f);
                float o[8] = {a0[0] * dg * (float)(g0 & 0xffu), a0[1] * dg * (float)((g0 >> 8) & 0xffu), a0[2] * dg * (float)((g0 >> 16) & 0xffu), a0[3] * dg * (float)(g0 >> 24),
                              a1[0] * dg * (float)(g1 & 0xffu), a1[1] * dg * (float)((g1 >> 8) & 0xffu), a1[2] * dg * (float)((g1 >> 16) & 0xffu), a1[3] * dg * (float)(g1 >> 24)};
                if (hp) { const u32x4 p = pc[bj];
                    o[0] += bf_lo(p.x); o[1] += bf_hi(p.x); o[2] += bf_lo(p.y); o[3] += bf_hi(p.y); o[4] += bf_lo(p.z); o[5] += bf_hi(p.z); o[6] += bf_lo(p.w); o[7] += bf_hi(p.w); }
                if constexpr (SECOND) { u32x2 w8; w8.x = cvt_pk4_fp8(o[0] * sc8, o[1] * sc8, o[2] * sc8, o[3] * sc8); w8.y = cvt_pk4_fp8(o[4] * sc8, o[5] * sc8, o[6] * sc8, o[7] * sc8);
                    *(u32x2*)(out8 + off + HALF * bj) = w8; }
                else { u32x4 w; w.x = cvt_pk_bf16(o[0], o[1]); w.y = cvt_pk_bf16(o[2], o[3]); w.z = cvt_pk_bf16(o[4], o[5]); w.w = cvt_pk_bf16(o[6], o[7]);
                    *(u32x4*)(out + off + HALF * bj) = w; }
            }
            gc[0] = gn[0]; gc[1] = gn[1]; pc[0] = pn_[0]; pc[1] = pn_[1];
        }
#undef EG_LOAD
#undef EG_OFF
    }
};

struct EpiMix {
    static constexpr bool PERM = true, AFTER_DRAIN = false;
    const float* x; float* out; bf16_t* h1b; float* ssqp; float dsc;
    __device__ __forceinline__ void operator()(const f32x4 (&acc)[2][2][4][2], const Unit& u, int wr, int wc, int fr_in, int fq_in) const {
        int fr = fr_in, fq = fq_in; asm volatile("" : "+v"(fr), "+v"(fq));
        const int rowt = u.pm * BM + wr * 64 + fr, colb = u.pn * BM + 32 * wc + 8 * fq;
        f32x4 xc[4], xn[4];
#define EM_ROW(s) (rowt + ((s) >> 2) * HALF + ((s) & 3) * 16)
#define EM_LOAD(X, s) do { const float* p_ = x + (size_t)EM_ROW(s) * 1024 + colb; X[0] = *(const f32x4*)(p_); X[1] = *(const f32x4*)(p_ + 4); X[2] = *(const f32x4*)(p_ + HALF); X[3] = *(const f32x4*)(p_ + HALF + 4); } while (0)
        EM_LOAD(xc, 0);
#pragma unroll
        for (int s = 0; s < 8; ++s) {
            if (s < 7) EM_LOAD(xn, s + 1);
            const int ai = s >> 2, m = s & 3; const int row = EM_ROW(s);
            const size_t off = (size_t)row * 1024 + colb;
            float ss = 0.f;
#pragma unroll
            for (int bj = 0; bj < 2; ++bj) {
                const f32x4 h0 = xc[2 * bj] + acc[ai][bj][m][0] * dsc, h1 = xc[2 * bj + 1] + acc[ai][bj][m][1] * dsc;
                if (out) { *(f32x4*)(out + off + HALF * bj) = h0; *(f32x4*)(out + off + HALF * bj + 4) = h1; }
                ss += (h0[0] * h0[0] + h0[1] * h0[1]) + (h0[2] * h0[2] + h0[3] * h0[3]) + (h1[0] * h1[0] + h1[1] * h1[1]) + (h1[2] * h1[2] + h1[3] * h1[3]);
                u32x4 w; w.x = cvt_pk_bf16(h0[0], h0[1]); w.y = cvt_pk_bf16(h0[2], h0[3]); w.z = cvt_pk_bf16(h1[0], h1[1]); w.w = cvt_pk_bf16(h1[2], h1[3]);
                *(u32x4*)(h1b + off + HALF * bj) = w;
            }
            ss += __shfl_xor(ss, 16); ss += __shfl_xor(ss, 32);
            if (fq == 0) ssqp[(size_t)row * 16 + u.pn * 4 + wc] = ss;
            xc[0] = xn[0]; xc[1] = xn[1]; xc[2] = xn[2]; xc[3] = xn[3];
        }
#undef EM_LOAD
#undef EM_ROW
    }
};

struct EpiQ2 {
    static constexpr bool PERM = true, AFTER_DRAIN = false;
    bf16_t* q2; float dsc;
    __device__ __forceinline__ void operator()(const f32x4 (&acc)[2][2][4][2], const Unit& u, int wr, int wc, int fr_in, int fq_in) const {
        int fr = fr_in, fq = fq_in; asm volatile("" : "+v"(fr), "+v"(fq));
        const bool lo = fr < 8;
        const int rowt = u.pm * BM + wr * 64 + (fr & 7), colb = u.pn * BM + 64 * wc + 8 * fq + (lo ? 0 : 32);
#pragma unroll
        for (int ai = 0; ai < 2; ++ai)
#pragma unroll
            for (int m = 0; m < 4; ++m) {
                const int row = rowt + ai * HALF + m * 16;
                u32x4 d[2];
#pragma unroll
                for (int bj = 0; bj < 2; ++bj) {
                    const f32x4 v0 = acc[ai][bj][m][0] * dsc, v1 = acc[ai][bj][m][1] * dsc;
                    d[bj].x = cvt_pk_bf16(v0[0], v0[1]); d[bj].y = cvt_pk_bf16(v0[2], v0[3]); d[bj].z = cvt_pk_bf16(v1[0], v1[1]); d[bj].w = cvt_pk_bf16(v1[2], v1[3]);
                }
                u32x4 w1, w2; xchg_rows(d[0], d[1], lo, w1, w2);
                *(u32x4*)(q2 + (size_t)row * 2048 + colb) = w1;
                *(u32x4*)(q2 + (size_t)(row + 8) * 2048 + colb) = w2;
            }
    }
};
typedef int pg8_v8i __attribute__((ext_vector_type(8)));
typedef int pg8_v4i __attribute__((ext_vector_type(4)));
__device__ __forceinline__ pg8_v8i pg8_cat(const bf16x8 a, const bf16x8 b) { const pg8_v4i x = __builtin_bit_cast(pg8_v4i, a), y = __builtin_bit_cast(pg8_v4i, b); return __builtin_shufflevector(x, y, 0, 1, 2, 3, 4, 5, 6, 7); }
template <class Epi, class Sched, bool ALIGN_EPI = false, bool SP2 = false, bool F8 = false>
__device__ __forceinline__ void gemm_phase(int wv  , PG8_LAS unsigned char* lds, const Gemm g, const Sched& S, const Epi& E) {
    int tid_ = wv * 64 + mk_lane(); asm volatile("" : "+v"(tid_));
    const int tid = tid_, wid = wv, lane = tid & 63, wr = wid >> 2, wc = wid & 3, fr = lane & 15, fq = lane >> 4;
    const int K = g.K, nt = K / BK;
    unsigned voffA[2], voffB[2];
#pragma unroll
    for (int i = 0; i < 2; ++i) { int R, C; stage_rc(tid * 16 + i * 8192, R, C); const int Rb = Epi::PERM ? ((R & ~31) + perm32(R & 31)) : R;
        voffA[i] = (unsigned)(R * K + C) * 2u; voffB[i] = (unsigned)(Rb * K + C) * 2u; }
    const size_t kstep = (size_t)(BK * 2);
    const size_t hstep = (size_t)HALF * K * 2;
    const size_t tstep = 2 * hstep;
    const unsigned ldsw = (unsigned)wid * 1024u;
    const int aoff = lds_byte(wr * 64 + fr, fq * 8), boff = lds_byte(wc * 32 + fr, fq * 8);
#define PG8_SA(b, h) (((b) * 2 + (h)) * HTB)
#define PG8_SB(b, h) ((4 + (b) * 2 + (h)) * HTB)
#define PG8_STAGE(bufoff, gbase, voff) do { _Pragma("unroll") for (int _i = 0; _i < 2; ++_i) \
        __builtin_amdgcn_global_load_lds((const unsigned*)((const char*)(gbase) + (voff)[_i]), (PG8_LAS unsigned*)(lds + (bufoff) + ldsw + _i * 8192), 16, 0, 0); } while (0)
#define PG8_LDA(dst, b, h) do { _Pragma("unroll") for (int m = 0; m < 4; ++m) { const bf16x8 l0_ = *(const PG8_LAS bf16x8*)(lds + PG8_SA(b, h) + aoff + m * 2048), l1_ = *(const PG8_LAS bf16x8*)(lds + PG8_SA(b, h) + aoff + m * 2048 + 1024); \
        if constexpr (F8) dst##8[m] = pg8_cat(l0_, l1_); else { dst[m][0] = l0_; dst[m][1] = l1_; } } } while (0)
#define PG8_LDB(dst, b, h) do { _Pragma("unroll") for (int n = 0; n < 2; ++n) { const bf16x8 l0_ = *(const PG8_LAS bf16x8*)(lds + PG8_SB(b, h) + boff + n * 2048), l1_ = *(const PG8_LAS bf16x8*)(lds + PG8_SB(b, h) + boff + n * 2048 + 1024); \
        if constexpr (F8) dst##8[n] = pg8_cat(l0_, l1_); else { dst[n][0] = l0_; dst[n][1] = l1_; } } } while (0)
#define PG8_MMA(ai, bj, At, Bt) do { __builtin_amdgcn_s_setprio(1); if constexpr (F8) { _Pragma("unroll") for (int m = 0; m < 4; ++m) _Pragma("unroll") for (int n = 0; n < 2; ++n) \
        acc[ai][bj][m][n] = __builtin_amdgcn_mfma_scale_f32_16x16x128_f8f6f4(Bt##8[n], At##8[m], acc[ai][bj][m][n], 0, 0, 0, 0x7f7f7f7f, 0, 0x7f7f7f7f); \
        asm volatile("" : "+v"(acc[ai][bj][0][0]), "+v"(acc[ai][bj][0][1]), "+v"(acc[ai][bj][1][0]), "+v"(acc[ai][bj][1][1]), "+v"(acc[ai][bj][2][0]), "+v"(acc[ai][bj][2][1]), "+v"(acc[ai][bj][3][0]), "+v"(acc[ai][bj][3][1]));   } else { \
        _Pragma("unroll") for (int m = 0; m < 4; ++m) _Pragma("unroll") for (int n = 0; n < 2; ++n) _Pragma("unroll") for (int k = 0; k < 2; ++k) \
        acc[ai][bj][m][n] = __builtin_amdgcn_mfma_f32_16x16x32_bf16(Bt[n][k], At[m][k], acc[ai][bj][m][n], 0, 0, 0); } __builtin_amdgcn_s_setprio(0); } while (0)
#define PG8_WAIT_V(n) asm volatile("s_waitcnt vmcnt(" #n ")" ::: "memory")
#define PG8_WAIT_L(n) asm volatile("s_waitcnt lgkmcnt(" #n ")" ::: "memory")
#define PG8_BAR __builtin_amdgcn_s_barrier()
#define PG8_SCHED __builtin_amdgcn_sched_barrier(0)
    Unit cur, nxt; int ui = 0;
    if (!S.next(0, cur)) return;
    f32x4 acc[2][2][4][2];
#pragma unroll
    for (int a = 0; a < 2; ++a)
#pragma unroll
        for (int b = 0; b < 2; ++b)
#pragma unroll
            for (int m = 0; m < 4; ++m)
#pragma unroll
                for (int n = 0; n < 2; ++n) { acc[a][b][m][n] = (f32x4){0.f, 0.f, 0.f, 0.f}; }
    bf16x8 At[4][2], B0[2][2], B1[2][2]; pg8_v8i At8[4], B08[2], B18[2];
    const char* cA = (const char*)g.A + (size_t)cur.pm * tstep; const char* cB = (const char*)g.Bt + (size_t)cur.pn * tstep;
    S.a_ready(cur);
    if constexpr (SP2) {
        PG8_STAGE(PG8_SB(0, 0), cB, voffB); PG8_STAGE(PG8_SB(0, 1), cB + hstep, voffB); PG8_STAGE(PG8_SA(0, 0), cA, voffA); PG8_STAGE(PG8_SA(0, 1), cA + hstep, voffA);
        if (wr == 1) PG8_BAR;
        PG8_WAIT_V(2); PG8_BAR;
        PG8_STAGE(PG8_SB(1, 0), cB + kstep, voffB); PG8_STAGE(PG8_SA(1, 0), cA + kstep, voffA); PG8_STAGE(PG8_SB(1, 1), cB + hstep + kstep, voffB);
        PG8_WAIT_V(6); PG8_BAR;
    } else {
        PG8_STAGE(PG8_SB(0, 0), cB, voffB); PG8_STAGE(PG8_SA(0, 0), cA, voffA); PG8_STAGE(PG8_SB(0, 1), cB + hstep, voffB); PG8_STAGE(PG8_SA(0, 1), cA + hstep, voffA);
        if (wr == 1) PG8_BAR;
        PG8_WAIT_V(4); PG8_BAR;
        PG8_STAGE(PG8_SB(1, 0), cB + kstep, voffB); PG8_STAGE(PG8_SA(1, 0), cA + kstep, voffA); PG8_STAGE(PG8_SB(1, 1), cB + hstep + kstep, voffB);
        PG8_WAIT_V(6); PG8_BAR;
    }
    for (;;) {
        const bool has_next = S.next(ui + 1, nxt);
        const char* nA = has_next ? (const char*)g.A + (size_t)nxt.pm * tstep : cA; const char* nB = has_next ? (const char*)g.Bt + (size_t)nxt.pn * tstep : cB;
#pragma nounroll
        for (int t = 0; t < nt; t += 2) {
            asm volatile("" : "+v"(voffA[0]), "+v"(voffA[1]), "+v"(voffB[0]), "+v"(voffB[1]));
            const bool last = (t == nt - 2);
            const char* a1 = cA + (size_t)(t + 1) * kstep;
            const char* a2 = last ? nA : cA + (size_t)(t + 2) * kstep; const char* b2 = last ? nB : cB + (size_t)(t + 2) * kstep;
            const char* a3 = a2 + kstep; const char* b3 = b2 + kstep;
            if (last && has_next) S.a_ready(nxt);
            if constexpr (SP2) {
            PG8_LDB(B0, 0, 0); PG8_LDB(B1, 0, 1); PG8_SCHED; PG8_LDA(At, 0, 0); PG8_STAGE(PG8_SA(1, 1), a1 + hstep, voffA);
            PG8_WAIT_V(8); PG8_WAIT_L(0); PG8_BAR; PG8_MMA(0, 0, At, B0); PG8_MMA(0, 1, At, B1); PG8_BAR; PG8_SCHED;
            PG8_LDA(At, 0, 1); PG8_STAGE(PG8_SB(0, 0), b2, voffB); PG8_STAGE(PG8_SB(0, 1), b2 + hstep, voffB); PG8_STAGE(PG8_SA(0, 0), a2, voffA);
            PG8_WAIT_V(8); PG8_WAIT_L(0); PG8_BAR; PG8_MMA(1, 0, At, B0); PG8_MMA(1, 1, At, B1); PG8_BAR; PG8_SCHED;
            PG8_LDB(B0, 1, 0); PG8_LDB(B1, 1, 1); PG8_SCHED; PG8_LDA(At, 1, 0); PG8_STAGE(PG8_SA(0, 1), a2 + hstep, voffA);
            PG8_WAIT_V(8); PG8_WAIT_L(0); PG8_BAR; PG8_MMA(0, 0, At, B0); PG8_MMA(0, 1, At, B1); PG8_BAR; PG8_SCHED;
            PG8_LDA(At, 1, 1); PG8_STAGE(PG8_SB(1, 0), b3, voffB); PG8_STAGE(PG8_SB(1, 1), b3 + hstep, voffB); PG8_STAGE(PG8_SA(1, 0), a3, voffA);
            PG8_WAIT_V(8); PG8_WAIT_L(0); PG8_BAR; PG8_MMA(1, 0, At, B0); PG8_MMA(1, 1, At, B1); PG8_BAR; PG8_SCHED;
            } else {
            PG8_LDB(B0, 0, 0); PG8_SCHED; PG8_LDA(At, 0, 0); PG8_STAGE(PG8_SA(1, 1), a1 + hstep, voffA);
            PG8_WAIT_L(8); PG8_BAR; PG8_WAIT_L(0); PG8_MMA(0, 0, At, B0); PG8_BAR; PG8_SCHED;
            PG8_LDB(B1, 0, 1); PG8_STAGE(PG8_SB(0, 0), b2, voffB);
            PG8_BAR; PG8_WAIT_L(0); PG8_MMA(0, 1, At, B1); PG8_BAR;
            PG8_LDA(At, 0, 1); PG8_STAGE(PG8_SA(0, 0), a2, voffA);
            PG8_BAR; PG8_WAIT_L(0); PG8_MMA(1, 0, At, B0); PG8_BAR; PG8_SCHED;
            PG8_STAGE(PG8_SB(0, 1), b2 + hstep, voffB);
            PG8_WAIT_V(6); PG8_BAR; PG8_MMA(1, 1, At, B1); PG8_BAR;
            PG8_LDB(B0, 1, 0); PG8_SCHED; PG8_LDA(At, 1, 0); PG8_STAGE(PG8_SA(0, 1), a2 + hstep, voffA);
            PG8_WAIT_L(8); PG8_BAR; PG8_WAIT_L(0); PG8_MMA(0, 0, At, B0); PG8_BAR; PG8_SCHED;
            PG8_LDB(B1, 1, 1); PG8_STAGE(PG8_SB(1, 0), b3, voffB);
            PG8_BAR; PG8_WAIT_L(0); PG8_MMA(0, 1, At, B1); PG8_BAR;
            PG8_LDA(At, 1, 1); PG8_STAGE(PG8_SA(1, 0), a3, voffA);
            PG8_BAR; PG8_WAIT_L(0); PG8_MMA(1, 0, At, B0); PG8_BAR; PG8_SCHED;
            PG8_STAGE(PG8_SB(1, 1), b3 + hstep, voffB);
            PG8_WAIT_V(6); PG8_BAR; PG8_MMA(1, 1, At, B1); PG8_BAR;
            }
        }
        if constexpr (ALIGN_EPI) { if (wr == 0) PG8_BAR; }
        if constexpr (!Epi::AFTER_DRAIN) { E(acc, cur, wr, wc, fr, fq); S.done(cur); }
        if (!has_next) break;
#pragma unroll
        for (int a = 0; a < 2; ++a)
#pragma unroll
            for (int b = 0; b < 2; ++b)
#pragma unroll
                for (int m = 0; m < 4; ++m)
#pragma unroll
                    for (int n = 0; n < 2; ++n) { acc[a][b][m][n] = (f32x4){0.f, 0.f, 0.f, 0.f}; }
        cur = nxt; cA = nA; cB = nB; ++ui;
        if constexpr (ALIGN_EPI) { if (wr == 1) PG8_BAR; }
    }
    PG8_WAIT_V(0);
    if constexpr (!ALIGN_EPI) { if (wr == 0) PG8_BAR; }
    PG8_BAR;
    if constexpr (Epi::AFTER_DRAIN) { E.fused(acc, cur, wr, wc, fr, fq, lds, wid, lane); S.done(cur); }
#undef PG8_SA
#undef PG8_SB
#undef PG8_STAGE
#undef PG8_LDA
#undef PG8_LDB
#undef PG8_MMA
#undef PG8_WAIT_V
#undef PG8_WAIT_L
#undef PG8_BAR
#undef PG8_SCHED
}
}
#include <hip/hip_bf16.h>
#include <cmath>
namespace attn_body {
using bf16=__hip_bfloat16;
using bf16x8=__attribute__((ext_vector_type(8)))short;
using s16x4=__attribute__((ext_vector_type(4)))short;
using f32x16=__attribute__((ext_vector_type(16)))float;
using u32x4=__attribute__((ext_vector_type(4)))unsigned;
typedef float f32x4_t __attribute__((ext_vector_type(4)));
constexpr int D=64,PQKV=512;
constexpr int NW=8,QBLK=32,QB=QBLK*NW,KVBLK=64;
constexpr int ATTN_UNIT_ROWS=QB;
__device__ __forceinline__ int crow(int r,int hi){return (r&3)+8*(r>>2)+4*hi;}
#define SBAR() __builtin_amdgcn_sched_barrier(0)
__device__ __forceinline__ void cmask(f32x16&p0,f32x16&p1,int jb,int qrel,int hi){
  const float NEG=-INFINITY; int kb=64*jb+4*hi;
  #pragma unroll
  for(int r=0;r<16;++r){int kv=kb+(r&3)+8*(r>>2); if(kv>qrel)p0[r]=NEG; if(kv+32>qrel)p1[r]=NEG;}
}

__device__ __forceinline__ void mask_all(f32x16&p0,f32x16&p1){const float NEG=-INFINITY;
  #pragma unroll
  for(int r=0;r<16;++r){p0[r]=NEG;p1[r]=NEG;}}
__device__ __forceinline__ void mask_meta(f32x16&p0,f32x16&p1){const float NEG=-INFINITY;
  #pragma unroll
  for(int r=8;r<16;++r)p0[r]=NEG;
  #pragma unroll
  for(int r=0;r<16;++r)p1[r]=NEG;}
constexpr int NSLOT=3, SLOTB=8192;
constexpr int LDS_K=0, LDS_V=NSLOT*SLOTB, LDS_WS=2*NSLOT*SLOTB, LDS_OST=LDS_WS+NW*64*4, LDS_BIAS=LDS_OST+NW*4096, LDS_ST=LDS_BIAS+34*64*4, LDS_BYTES=LDS_ST+NW*64*4;
constexpr float C2=0.125f*1.4426950408889634f;
__device__ __forceinline__ void glds16(const void*gsrc,unsigned lds_dst){unsigned keep;
  asm volatile("s_mov_b32 %0, m0\n\ts_mov_b32 m0, %2\n\ts_nop 0\n\tglobal_load_lds_dwordx4 %1, off\n\ts_mov_b32 m0, %0":"=&s"(keep):"v"(gsrc),"s"(lds_dst):"memory");}
__device__ __forceinline__ float max3f(float a,float b,float c){float r;asm("v_max3_f32 %0, %1, %2, %3":"=v"(r):"v"(a),"v"(b),"v"(c));return r;}
__device__ __forceinline__ float max2f(float a,float b){float r;asm("v_max_f32_e32 %0, %1, %2":"=v"(r):"v"(a),"v"(b));return r;}
__device__ __forceinline__ float fadd_s(float a,float b){float r;asm("v_add_f32_e32 %0, %1, %2":"=v"(r):"v"(a),"v"(b));return r;}
__device__ __forceinline__ float fsub_s(float a,float b){float r;asm("v_sub_f32_e32 %0, %1, %2":"=v"(r):"v"(a),"v"(b));return r;}
typedef float f32x2_t __attribute__((ext_vector_type(2))); typedef __bf16 bf16x2_t __attribute__((ext_vector_type(2)));
__device__ __forceinline__ unsigned cvtpk_s(float lo,float hi){f32x2_t v={lo,hi};bf16x2_t b=__builtin_convertvector(v,bf16x2_t);return __builtin_bit_cast(unsigned,b);}
#define WAIT_BAR(N) asm volatile("s_waitcnt vmcnt(" #N ") lgkmcnt(0)\n\ts_barrier":::"memory")

__device__ __forceinline__ void qkt(f32x16&p0,f32x16&p1,const char*Kslot,const bf16x8*qr,const f32x16&negm,int r32,int hi){
  const char*kb=Kslot+hi*1024+r32*16;
  #pragma unroll
  for(int d0=0;d0<4;++d0){
    const bf16x8 b0=*reinterpret_cast<const bf16x8*>(kb+d0*2048);
    const bf16x8 b1=*reinterpret_cast<const bf16x8*>(kb+d0*2048+512);
    if(d0==0){p0=__builtin_amdgcn_mfma_f32_32x32x16_bf16(b0,qr[0],negm,0,0,0);p1=__builtin_amdgcn_mfma_f32_32x32x16_bf16(b1,qr[0],negm,0,0,0);}
    else{p0=__builtin_amdgcn_mfma_f32_32x32x16_bf16(b0,qr[d0],p0,0,0,0);p1=__builtin_amdgcn_mfma_f32_32x32x16_bf16(b1,qr[d0],p1,0,0,0);}}
}
typedef __attribute__((address_space(3))) const char* lds_cptr;
typedef short v4i16_t __attribute__((ext_vector_type(4)));
__device__ __forceinline__ void kload8(bf16x8*kf,lds_cptr kp){
  kf[0]=*(const __attribute__((address_space(3))) bf16x8*)(kp);      kf[1]=*(const __attribute__((address_space(3))) bf16x8*)(kp+512);
  kf[2]=*(const __attribute__((address_space(3))) bf16x8*)(kp+2048); kf[3]=*(const __attribute__((address_space(3))) bf16x8*)(kp+2560);
  kf[4]=*(const __attribute__((address_space(3))) bf16x8*)(kp+4096); kf[5]=*(const __attribute__((address_space(3))) bf16x8*)(kp+4608);
  kf[6]=*(const __attribute__((address_space(3))) bf16x8*)(kp+6144); kf[7]=*(const __attribute__((address_space(3))) bf16x8*)(kp+6656);
}
__device__ __forceinline__ void kload2(bf16x8*kf,lds_cptr kp,int j){ kf[2*j]=*(const __attribute__((address_space(3))) bf16x8*)(kp+j*2048); kf[2*j+1]=*(const __attribute__((address_space(3))) bf16x8*)(kp+j*2048+512); }
__device__ __forceinline__ s16x4 vtr(lds_cptr p){ return __builtin_bit_cast(s16x4,__builtin_amdgcn_ds_read_tr16_b64_v4i16((__attribute__((address_space(3))) v4i16_t*)p)); }
__device__ __forceinline__ float rowmax(const f32x16&p0,const f32x16&p1){
  float a=max3f(p0[0],p0[1],p1[0]),b=max3f(p0[2],p0[3],p1[1]);a=max3f(a,p1[2],p1[3]);
  #pragma unroll
  for(int r=4;r<16;r+=4){a=max3f(a,p0[r],p0[r+1]);b=max3f(b,p0[r+2],p0[r+3]);a=max3f(a,p1[r],p1[r+1]);b=max3f(b,p1[r+2],p1[r+3]);}
  const float m=max2f(a,b);
  auto rr=__builtin_amdgcn_permlane32_swap(__float_as_uint(m),__float_as_uint(m),false,false);
  return max2f(__uint_as_float(rr[0]),__uint_as_float(rr[1]));
}
__device__ __forceinline__ void pv(f32x16*o,int vb,bf16x8 pa0,bf16x8 pa1,bf16x8 pa2,bf16x8 pa3){
  #pragma unroll
  for(int d0=0;d0<2;++d0){s16x4 lo[4],hi[4];
    #pragma unroll
    for(int ks=0;ks<4;++ks){
      asm volatile("ds_read_b64_tr_b16 %0,%1 offset:%c2":"=&v"(lo[ks]):"v"(vb),"i"(d0*4096+ks*1024):"memory");
      asm volatile("ds_read_b64_tr_b16 %0,%1 offset:%c2":"=&v"(hi[ks]):"v"(vb),"i"(d0*4096+ks*1024+512):"memory");}
    asm volatile("s_waitcnt lgkmcnt(0)":::"memory");SBAR();
    #define PK(k) (bf16x8){lo[k][0],lo[k][1],lo[k][2],lo[k][3],hi[k][0],hi[k][1],hi[k][2],hi[k][3]}
    o[d0]=__builtin_amdgcn_mfma_f32_32x32x16_bf16(pa0,PK(0),o[d0],0,0,0);
    o[d0]=__builtin_amdgcn_mfma_f32_32x32x16_bf16(pa1,PK(1),o[d0],0,0,0);
    o[d0]=__builtin_amdgcn_mfma_f32_32x32x16_bf16(pa2,PK(2),o[d0],0,0,0);
    o[d0]=__builtin_amdgcn_mfma_f32_32x32x16_bf16(pa3,PK(3),o[d0],0,0,0);
    #undef PK
  }
}

#ifndef ATTN_STORE16
#define ATTN_STORE16(p,v) (*(u32x4*)(p)=(v))
#endif
template<int THRL,bool FOX,bool KN=false> __device__ __forceinline__ void attn_unit(int wv,int qb,const bf16*Qb,const bf16*__restrict__ Kb,const bf16*__restrict__ Vb,bf16*Ob,int OP,const float*__restrict__ cbv,char*shm){
  const int tid=wv*64+mk_lane_v(),lane=tid&63,r32=lane&31,hi=lane>>5; const int wid=wv;
  const int q0=qb*QB; constexpr int DM=PQKV;
  const bf16*Qw=Qb+(long)(wid*QBLK)*DM;
  const bf16*Kh=Kb,*Vh=Vb;
  const unsigned lds0=(unsigned)(uintptr_t)shm;
  float*wsf=(float*)(shm+LDS_WS)+wid*64;
  const bf16*ksrc=Kh+(long)lane*DM+wid*8;
  const bf16*vsrc=Vh+(long)(16*(wid&3)+(lane>>2))*DM+(wid>>2)*32+(lane&3)*8;
  const unsigned kdst=lds0+LDS_K+wid*1024, vdst=lds0+LDS_V+wid*1024;
  #define TROW(t) (((t)==0)?2048:64*((t)-1))
  #define DMA_K(t,slot) glds16(ksrc+(long)TROW(t)*DM,(unsigned)__builtin_amdgcn_readfirstlane(kdst+(slot)))
  #define DMA_V(t,slot) glds16(vsrc+(long)TROW(t)*DM,(unsigned)__builtin_amdgcn_readfirstlane(vdst+(slot)))
  const int vb0=(int)(lds0+LDS_V)+((lane>>4)&1)*32+(lane&3)*8+(4*hi+((lane&15)>>2))*64;
  const char*Kbase=shm+LDS_K; bf16x8 kf[8];
  const lds_cptr shm3=(lds_cptr)shm; const lds_cptr kp0=shm3+LDS_K+hi*1024+r32*16; const lds_cptr vp0=shm3+LDS_V+((lane>>4)&1)*32+(lane&3)*8+(4*hi+((lane&15)>>2))*64;
  const int NT=4*qb+5;
  float*biasL=(float*)(shm+LDS_BIAS);
  DMA_K(0,0);DMA_V(0,0);DMA_K(1,SLOTB);
  if(FOX){ const float ref=cbv[q0]; for(int e=tid;e<NT*64;e+=NW*64){const int t_=e>>6,k_=e&63; biasL[e]=cbv[TROW(t_)+k_]-ref;} }
  asm volatile("s_waitcnt vmcnt(0) lgkmcnt(0)\n\ts_barrier":::"memory");
  const __attribute__((address_space(3))) float* bl3=(const __attribute__((address_space(3))) float*)(lds_cptr)shm + (LDS_BIAS>>2) + 4*hi;
  #define LOADCB(t,H) do{ if(FOX){ _Pragma("unroll") for(int g_=0;g_<4;++g_){ \
      const f32x4_t u0=*(const __attribute__((address_space(3))) f32x4_t*)(bl3+(t)*64+32*(H)+8*g_); \
      negm[4*g_]=u0[0]-mhat;negm[4*g_+1]=u0[1]-mhat;negm[4*g_+2]=u0[2]-mhat;negm[4*g_+3]=u0[3]-mhat; } \
      asm volatile("":"+v"(negm)); } }while(0)
  #define ADDB(P,t,H) do{ _Pragma("unroll") for(int g_=0;g_<4;++g_){ const f32x4_t u0=*(const __attribute__((address_space(3))) f32x4_t*)(bl3+(t)*64+32*(H)+8*g_); P[4*g_]+=u0[0];P[4*g_+1]+=u0[1];P[4*g_+2]+=u0[2];P[4*g_+3]+=u0[3]; } }while(0)
  bf16x8 qr[4];
  #pragma unroll
  for(int d0=0;d0<4;++d0)qr[d0]=*reinterpret_cast<const bf16x8*>(&Qw[(long)r32*DM+d0*16+hi*8]);
  float mhat=0.f,l_reg=0.f;f32x16 o[2];o[0]=f32x16{};o[1]=f32x16{};f32x16 negm=f32x16{};asm volatile("":"+v"(negm));
  float*stw=(float*)(shm+LDS_ST)+wid*64;
  if(KN){ mhat=stw[r32]; l_reg=stw[32+r32]; asm volatile("s_waitcnt lgkmcnt(0)":::"memory"); _Pragma("unroll") for(int r=0;r<16;++r)negm[r]=-mhat; asm volatile("":"+v"(negm)); }
  const int qrel=wid*QBLK+r32;
  #define CMASK(P0,P1,t) do{int jb_=(t)-(NT-4); if(jb_>=0){ if(FOX)cmask(P0,P1,jb_,qrel,hi); else if(jb_>(wid>>1))mask_all(P0,P1);} }while(0)
  bool resc=false;
  #define START(P0,P1) do{ resc=false; \
    if(!KN){ const float rm=rowmax(P0,P1); const float dl=rm; mhat=fadd_s(mhat,dl); \
      _Pragma("unroll") for(int r=0;r<16;++r){P0[r]=fsub_s(P0[r],dl);P1[r]=fsub_s(P1[r],dl);} \
      if(!FOX){_Pragma("unroll") for(int r=0;r<16;++r)negm[r]=-mhat; asm volatile("":"+v"(negm));} } \
    _Pragma("unroll") for(int r=0;r<16;++r)P0[r]=__builtin_amdgcn_exp2f(P0[r]); }while(0)
  #define RESC() do{ if(resc){ asm volatile("s_waitcnt lgkmcnt(0)":::"memory"); \
      _Pragma("unroll") for(int d_=0;d_<2;++d_) _Pragma("unroll") for(int r=0;r<16;++r)o[d_][r]*=wsf[crow(r,hi)]; } }while(0)
  f32x16 pA0,pA1,pB0,pB1;
  int sl_prev=0,sl_cur=0,sl_next=SLOTB;
  #define ROT() do{sl_prev=sl_cur;sl_cur=sl_next;sl_next=(sl_next==(NSLOT-1)*SLOTB)?0:sl_next+SLOTB;}while(0)
  DMA_K(2,2*SLOTB);
  WAIT_BAR(3);
  qkt(pA0,pA1,Kbase,qr,negm,r32,hi);asm volatile("s_nop 15\n\ts_nop 7":"+v"(pA0),"+v"(pA1)); if(FOX){ADDB(pA0,0,0);ADDB(pA1,0,1);} mask_meta(pA0,pA1);
  START(pA0,pA1);
  _Pragma("unroll") for(int r=0;r<16;++r)pA1[r]=__builtin_amdgcn_exp2f(pA1[r]);
  WAIT_BAR(0);
  DMA_K(3,0);DMA_V(1,SLOTB);
  ROT();
  kload8(kf,kp0+sl_cur);
  WAIT_BAR(2);
  s16x4 vlo[8],vhi[8]; u32x4 pw0,pw1,pw2,pw3;
  #define PKW(P,B) cvtpk_s(P[B],P[B+1])
  #define PAF(k) __builtin_bit_cast(bf16x8,pw##k)
  #define VFR(i) (bf16x8){vlo[i][0],vlo[i][1],vlo[i][2],vlo[i][3],vhi[i][0],vhi[i][1],vhi[i][2],vhi[i][3]}
  #define PIN(x) asm volatile("":"+v"(x))
  #define MX3(a,b,c) __builtin_fmaxf(__builtin_fmaxf((a),(b)),(c))
  #define GAPA(MF,A0,A1,A2,A3,W0,W1,PW) do{ MF; if(!KN){sacc+=A0; sacc+=A1; sacc+=A2; sacc+=A3; PIN(sacc);} W0; W1; PIN(PW); SBAR(); }while(0)
  #define EX(v) __builtin_amdgcn_exp2f(v)
  #define GAPB(MF,X,B) do{ MF; X[B]=EX(X[B]); X[B+1]=EX(X[B+1]); X[B+2]=EX(X[B+2]); X[B+3]=EX(X[B+3]); PIN(X); SBAR(); }while(0)
  #define VRD(i) do{ vlo[i]=vtr(vp_+(((i)>>2)*4096+((i)&3)*1024)); vhi[i]=vtr(vp_+(((i)>>2)*4096+((i)&3)*1024+512)); }while(0)
  #define KRD(G,j) do{ if(G){ kload2(kf,kp0+sl_next,j); SBAR(); } }while(0)
  #define STEP(C0,C1,P0,P1,t,GK,GV,GL) do{ SBAR(); LOADCB(t,0); SBAR(); \
    const lds_cptr vp_=vp0+sl_prev; \
    VRD(0); SBAR(); float sacc=(P0[0]+P0[1]); \
    GAPA(C0=__builtin_amdgcn_mfma_f32_32x32x16_bf16(kf[0],qr[0],negm,0,0,0), P0[2],P0[3],P0[4],P0[5],     pw0[0]=PKW(P0,0), pw0[1]=PKW(P0,2), pw0); \
    VRD(4); SBAR(); LOADCB(t,1); SBAR(); GAPA(C1=__builtin_amdgcn_mfma_f32_32x32x16_bf16(kf[1],qr[0],negm,0,0,0), P0[6],P0[7],P0[8],P0[9],     pw0[2]=PKW(P0,4), pw0[3]=PKW(P0,6), pw0); \
    VRD(1); SBAR(); GAPA(C0=__builtin_amdgcn_mfma_f32_32x32x16_bf16(kf[2],qr[1],C0,0,0,0),   P0[10],P0[11],P0[12],P0[13], pw1[0]=PKW(P0,8), pw1[1]=PKW(P0,10), pw1); \
    VRD(5); SBAR(); GAPA(C1=__builtin_amdgcn_mfma_f32_32x32x16_bf16(kf[3],qr[1],C1,0,0,0),   P0[14],P0[15],P1[0],P1[1],   pw1[2]=PKW(P0,12),pw1[3]=PKW(P0,14), pw1); \
    VRD(2); SBAR(); GAPA(C0=__builtin_amdgcn_mfma_f32_32x32x16_bf16(kf[4],qr[2],C0,0,0,0),   P1[2],P1[3],P1[4],P1[5],     pw2[0]=PKW(P1,0), pw2[1]=PKW(P1,2), pw2); \
    VRD(6); SBAR(); GAPA(C1=__builtin_amdgcn_mfma_f32_32x32x16_bf16(kf[5],qr[2],C1,0,0,0),   P1[6],P1[7],P1[8],P1[9],     pw2[2]=PKW(P1,4), pw2[3]=PKW(P1,6), pw2); \
    VRD(3); SBAR(); GAPA(C0=__builtin_amdgcn_mfma_f32_32x32x16_bf16(kf[6],qr[3],C0,0,0,0),   P1[10],P1[11],P1[12],P1[13], pw3[0]=PKW(P1,8), pw3[1]=PKW(P1,10), pw3); \
    VRD(7); SBAR(); GAPA(C1=__builtin_amdgcn_mfma_f32_32x32x16_bf16(kf[7],qr[3],C1,0,0,0),   P1[14],P1[15],0.f,0.f,       pw3[2]=PKW(P1,12),pw3[3]=PKW(P1,14), pw3); \
    if(!KN)l_reg+=sacc; \
    if(GK){DMA_K((t)+3,sl_cur);} if(GV){DMA_V((t)+1,sl_next);} \
    CMASK(C0,C1,t); \
    if(!KN){ float a=MX3(C0[0],C0[1],C1[0]),b=MX3(C0[2],C0[3],C1[1]); a=MX3(a,C1[2],C1[3]); \
      _Pragma("unroll") for(int r=4;r<16;r+=4){a=MX3(a,C0[r],C0[r+1]);b=MX3(b,C0[r+2],C0[r+3]);a=MX3(a,C1[r],C1[r+1]);b=MX3(b,C1[r+2],C1[r+3]);} \
      float rm=__builtin_fmaxf(a,b); { auto rr=__builtin_amdgcn_permlane32_swap(__float_as_uint(rm),__float_as_uint(rm),false,false); rm=__builtin_fmaxf(__uint_as_float(rr[0]),__uint_as_float(rr[1])); } \
      resc=false; \
      if(__builtin_expect(__any(rm>(float)THRL),0)){ const float dl=__builtin_fmaxf(rm,0.f); mhat+=dl; \
        _Pragma("unroll") for(int r=0;r<16;++r){C0[r]-=dl;C1[r]-=dl;} \
        if(!FOX){_Pragma("unroll") for(int r=0;r<16;++r)negm[r]=-mhat; asm volatile("":"+v"(negm));} \
        const float f=__builtin_amdgcn_exp2f(-dl); l_reg*=f; if(hi==0)wsf[r32]=f; resc=true; } } \
    SBAR(); \
    GAPB(o[0]=__builtin_amdgcn_mfma_f32_32x32x16_bf16(PAF(0),VFR(0),o[0],0,0,0), C0,0); \
    GAPB(o[1]=__builtin_amdgcn_mfma_f32_32x32x16_bf16(PAF(0),VFR(4),o[1],0,0,0), C0,4); \
    KRD(GL,0); GAPB(o[0]=__builtin_amdgcn_mfma_f32_32x32x16_bf16(PAF(1),VFR(1),o[0],0,0,0), C0,8); \
    KRD(GL,1); GAPB(o[1]=__builtin_amdgcn_mfma_f32_32x32x16_bf16(PAF(1),VFR(5),o[1],0,0,0), C0,12); \
    KRD(GL,2); GAPB(o[0]=__builtin_amdgcn_mfma_f32_32x32x16_bf16(PAF(2),VFR(2),o[0],0,0,0), C1,0); \
    KRD(GL,3); GAPB(o[1]=__builtin_amdgcn_mfma_f32_32x32x16_bf16(PAF(2),VFR(6),o[1],0,0,0), C1,4); \
    GAPB(o[0]=__builtin_amdgcn_mfma_f32_32x32x16_bf16(PAF(3),VFR(3),o[0],0,0,0), C1,8); \
    GAPB(o[1]=__builtin_amdgcn_mfma_f32_32x32x16_bf16(PAF(3),VFR(7),o[1],0,0,0), C1,12); \
    }while(0)
  int t=1;
  #undef CMASK
  #define CMASK(P0,P1,t) do{}while(0)
  for(;t+5<NT;t+=2){
    STEP(pB0,pB1,pA0,pA1,t,true,true,true);     WAIT_BAR(2); RESC(); ROT();
    STEP(pA0,pA1,pB0,pB1,t+1,true,true,true);   WAIT_BAR(2); RESC(); ROT();
  }
  #undef CMASK
  #define CMASK(P0,P1,t) do{int jb_=(t)-(NT-4); if(jb_>=0){ if(FOX)cmask(P0,P1,jb_,qrel,hi); else if(jb_>(wid>>1))mask_all(P0,P1);} }while(0)
  #define ENDW(tt) do{ if((tt)+3<NT){WAIT_BAR(2);} else if((tt)+2<NT){WAIT_BAR(1);} else {WAIT_BAR(0);} }while(0)
  for(;t+3<NT;t+=2){
    STEP(pB0,pB1,pA0,pA1,t,(t+3<NT),(t+1<NT),(t+1<NT));       ENDW(t);   RESC(); ROT();
    STEP(pA0,pA1,pB0,pB1,t+1,(t+4<NT),(t+2<NT),(t+2<NT));     ENDW(t+1); RESC(); ROT();
  }
  STEP(pB0,pB1,pA0,pA1,t,(t+3<NT),(t+1<NT),(t+1<NT));         ENDW(t);   RESC(); ROT();
  STEP(pA0,pA1,pB0,pB1,NT-1,false,false,false); RESC();
  { float sacc=pA0[0]+pA0[1]; _Pragma("unroll") for(int r=2;r<16;++r)sacc+=pA0[r]; _Pragma("unroll") for(int r=0;r<16;++r)sacc+=pA1[r]; if(!KN)l_reg+=sacc;
    pw0=(u32x4){PKW(pA0,0),PKW(pA0,2),PKW(pA0,4),PKW(pA0,6)};pw1=(u32x4){PKW(pA0,8),PKW(pA0,10),PKW(pA0,12),PKW(pA0,14)};pw2=(u32x4){PKW(pA1,0),PKW(pA1,2),PKW(pA1,4),PKW(pA1,6)};pw3=(u32x4){PKW(pA1,8),PKW(pA1,10),PKW(pA1,12),PKW(pA1,14)};
    SBAR(); pv(o,vb0+sl_cur,PAF(0),PAF(1),PAF(2),PAF(3)); }
  #undef PKW
  #undef PAF
  #undef VFR
  #undef PIN
  #undef MX3
  #undef GAPA
  #undef GAPB
  #undef EX
  #undef VRD
  #undef KRD
  #undef STEP
  #undef ENDW
  if(!KN){auto rr=__builtin_amdgcn_permlane32_swap(__float_as_uint(l_reg),__float_as_uint(l_reg),false,false);l_reg=__uint_as_float(rr[0])+__uint_as_float(rr[1]); if(!FOX&&hi==0){stw[r32]=mhat;stw[32+r32]=l_reg;} }
  if(hi==0)wsf[32+r32]=l_reg;asm volatile("s_waitcnt lgkmcnt(0)":::"memory");
  float rli[16];
  #pragma unroll
  for(int r=0;r<16;++r)rli[r]=__builtin_amdgcn_rcpf(wsf[32+crow(r,hi)]);
  bf16*Ow=Ob+(long)(wid*QBLK)*OP;
  if constexpr(FOX){ unsigned char*stg8=(unsigned char*)(shm+LDS_OST)+wid*4096;
    #pragma unroll
    for(int r=0;r<16;++r){const int orow=crow(r,hi); const float sc=rli[r]*16.0f;
      #pragma unroll
      for(int d0=0;d0<2;++d0){const float ov=o[d0][r]*sc; stg8[orow*64+d0*32+r32]=(unsigned char)(__builtin_amdgcn_cvt_pk_fp8_f32(ov,ov,0,false)&0xff);}}
    asm volatile("s_waitcnt lgkmcnt(0)":::"memory");
    unsigned char*Ow8=(unsigned char*)Ob+(long)(wid*QBLK)*OP;
    #pragma unroll
    for(int i=0;i<2;++i){const int row=i*16+(lane>>2),ch=lane&3; const u32x4 v=*(const u32x4*)(stg8+row*64+ch*16); ATTN_STORE16(Ow8+(long)row*OP+ch*16,v);} }
  else{ bf16*stg=(bf16*)(shm+LDS_OST)+wid*2048;
    #pragma unroll
    for(int r=0;r<16;++r){const int orow=crow(r,hi);
      #pragma unroll
      for(int d0=0;d0<2;++d0)stg[orow*64+d0*32+r32]=__float2bfloat16(o[d0][r]*rli[r]);}
    asm volatile("s_waitcnt lgkmcnt(0)":::"memory");
    #pragma unroll
    for(int i=0;i<4;++i){const int row=i*8+(lane>>3),ch=lane&7; const u32x4 v=*(const u32x4*)(stg+row*64+ch*8); ATTN_STORE16(Ow+(long)row*OP+ch*8,v);} }
  asm volatile("s_waitcnt lgkmcnt(0)\n\ts_barrier":::"memory");
  #undef DMA_K
  #undef TROW
  #undef LOADCB
  #undef ADDB
  #undef DMA_V
  #undef CMASK
  #undef START
  #undef RESC
  #undef ROT
}
constexpr int ATTN_LDS_BYTES=LDS_BYTES;
#undef SBAR
#undef WAIT_BAR
}
namespace attn_body {
constexpr int LDS_V2=LDS_ST+NW*64*4, LDS_BYTES_DV2=LDS_V2+NSLOT*SLOTB;
#define SBAR() __builtin_amdgcn_sched_barrier(0)
#define WAIT_BAR(N) asm volatile("s_waitcnt vmcnt(" #N ") lgkmcnt(0)\n\ts_barrier":::"memory")
template<int THRL,bool FOX,bool KN> __device__ __forceinline__ void attn_unit_dv2(int wv,int qb,const bf16*Qb,const bf16*__restrict__ Kb,const bf16*__restrict__ Vb,bf16*Ob,int OP,const float*__restrict__ cbv,char*shm){
  const int tid=wv*64+mk_lane_v(),lane=tid&63,r32=lane&31,hi=lane>>5; const int wid=wv;
  const int q0=qb*QB; constexpr int DM=PQKV;
  const bf16*Qw=Qb+(long)(wid*QBLK)*DM;
  const bf16*Kh=Kb,*Vh=Vb;
  const unsigned lds0=(unsigned)(uintptr_t)shm;
  float*wsf=(float*)(shm+LDS_WS)+wid*64;
  const bf16*ksrc=Kh+(long)lane*DM+wid*8;
  const bf16*vsrc=Vh+(long)(16*(wid&3)+(lane>>2))*DM+(wid>>2)*32+(lane&3)*8;
  const unsigned kdst=lds0+LDS_K+wid*1024, vdst=lds0+LDS_V+wid*1024, vdst2=lds0+LDS_V2+wid*1024;
  #define TROW(t) (((t)==0)?2048:64*((t)-1))
  #define DMA_K(t,slot) glds16(ksrc+(long)TROW(t)*DM,(unsigned)__builtin_amdgcn_readfirstlane(kdst+(slot)))
  #define DMA_V(t,slot) do{ glds16(vsrc+(long)TROW(t)*DM,(unsigned)__builtin_amdgcn_readfirstlane(vdst+(slot))); glds16(vsrc+64+(long)TROW(t)*DM,(unsigned)__builtin_amdgcn_readfirstlane(vdst2+(slot))); }while(0)
  const int vb0=(int)(lds0+LDS_V)+((lane>>4)&1)*32+(lane&3)*8+(4*hi+((lane&15)>>2))*64;
  const char*Kbase=shm+LDS_K; bf16x8 kf[8];
  const lds_cptr shm3=(lds_cptr)shm; const lds_cptr kp0=shm3+LDS_K+hi*1024+r32*16; const lds_cptr vp0=shm3+LDS_V+((lane>>4)&1)*32+(lane&3)*8+(4*hi+((lane&15)>>2))*64; const lds_cptr vp0b=vp0+(LDS_V2-LDS_V); const int vb0b=vb0+(LDS_V2-LDS_V);
  const int NT=4*qb+5;
  float*biasL=(float*)(shm+LDS_BIAS);
  if(FOX){ const float ref=cbv[q0]; for(int e=tid;e<NT*64;e+=NW*64){const int t_=e>>6,k_=e&63; biasL[e]=cbv[TROW(t_)+k_]-ref;} }
  asm volatile("s_waitcnt vmcnt(0) lgkmcnt(0)\n\ts_barrier":::"memory");
  const __attribute__((address_space(3))) float* bl3=(const __attribute__((address_space(3))) float*)(lds_cptr)shm + (LDS_BIAS>>2) + 4*hi;
  #define LOADCB(t,H) do{}while(0)
  #define ADDB(P,t,H) do{ _Pragma("unroll") for(int g_=0;g_<4;++g_){ const f32x4_t u0=*(const __attribute__((address_space(3))) f32x4_t*)(bl3+(t)*64+32*(H)+8*g_); P[4*g_]+=u0[0];P[4*g_+1]+=u0[1];P[4*g_+2]+=u0[2];P[4*g_+3]+=u0[3]; } }while(0)
  DMA_K(0,0);DMA_V(0,0);DMA_K(1,SLOTB);
  bf16x8 qr[4];
  #pragma unroll
  for(int d0=0;d0<4;++d0)qr[d0]=*reinterpret_cast<const bf16x8*>(&Qw[(long)r32*DM+d0*16+hi*8]);
  float mhat=0.f,l_reg=0.f;f32x16 o[4];o[0]=f32x16{};o[1]=f32x16{};o[2]=f32x16{};o[3]=f32x16{};const f32x16 zc=f32x16{};
  float*stw=(float*)(shm+LDS_ST)+wid*64;
  if(KN){ mhat=stw[r32]; l_reg=stw[32+r32]; asm volatile("s_waitcnt lgkmcnt(0)":::"memory"); }
  const int qrel=wid*QBLK+r32;
  #define CMASK(P0,P1,t) do{int jb_=(t)-(NT-4); if(jb_>=0){ if(FOX)cmask(P0,P1,jb_,qrel,hi); else if(jb_>(wid>>1))mask_all(P0,P1);} }while(0)
  bool resc=false;
  #define START(P0,P1) do{ resc=false; \
    if(!KN){ const float rm=rowmax(P0,P1); const float dl=rm; mhat=fadd_s(mhat,dl); \
      _Pragma("unroll") for(int r=0;r<16;++r){P0[r]=fsub_s(P0[r],dl);P1[r]=fsub_s(P1[r],dl);} \
      } \
    _Pragma("unroll") for(int r=0;r<16;++r)P0[r]=__builtin_amdgcn_exp2f(P0[r]); }while(0)
  #define RESC() do{ if(resc){ asm volatile("s_waitcnt lgkmcnt(0)":::"memory"); \
      _Pragma("unroll") for(int d_=0;d_<4;++d_) _Pragma("unroll") for(int r=0;r<16;++r)o[d_][r]*=wsf[crow(r,hi)]; } }while(0)
  f32x16 pA0,pA1,pB0,pB1;
  int sl_prev=0,sl_cur=0,sl_next=SLOTB;
  #define ROT() do{sl_prev=sl_cur;sl_cur=sl_next;sl_next=(sl_next==(NSLOT-1)*SLOTB)?0:sl_next+SLOTB;}while(0)
  DMA_K(2,2*SLOTB);
  WAIT_BAR(4);
  qkt(pA0,pA1,Kbase,qr,zc,r32,hi);asm volatile("s_nop 15\n\ts_nop 7":"+v"(pA0),"+v"(pA1)); if(FOX){ADDB(pA0,0,0);ADDB(pA1,0,1);} mask_meta(pA0,pA1);
  START(pA0,pA1);
  _Pragma("unroll") for(int r=0;r<16;++r)pA1[r]=__builtin_amdgcn_exp2f(pA1[r]);
  WAIT_BAR(0);
  DMA_K(3,0);DMA_V(1,SLOTB);
  ROT();
  kload8(kf,kp0+sl_cur);
  WAIT_BAR(3);
  s16x4 fl[4],fh[4]; u32x4 pw0,pw1,pw2,pw3;
  #define PKW(P,B) cvtpk_s(P[B],P[B+1])
  #define PAF(k) __builtin_bit_cast(bf16x8,pw##k)
  #define PIN(x) asm volatile("":"+v"(x))
  #define MX3(a,b,c) __builtin_fmaxf(__builtin_fmaxf((a),(b)),(c))
  #define GAPA(MF,A0,A1,A2,A3,W0,W1,PW) do{ MF; if(!KN){sacc+=A0; sacc+=A1; sacc+=A2; sacc+=A3; PIN(sacc);} W0; W1; PIN(PW); SBAR(); }while(0)
  #define EX(v) __builtin_amdgcn_exp2f(v)
  #define GAPB(MF,X,B) do{ MF; X[B]=EX(X[B]-mhat); X[B+1]=EX(X[B+1]-mhat); X[B+2]=EX(X[B+2]-mhat); X[B+3]=EX(X[B+3]-mhat); PIN(X); SBAR(); }while(0)
  #define KRD(G,j) do{ if(G){ kload2(kf,kp0+sl_next,j); SBAR(); } }while(0)
  #define STEP(C0,C1,P0,P1,t,GK,GV,GL) do{ SBAR(); LOADCB(t,0); SBAR(); \
    const lds_cptr vp_=vp0+sl_prev; const lds_cptr vp2_=vp0b+sl_prev; \
    float sacc=(P0[0]+P0[1]); \
    GAPA(C0=__builtin_amdgcn_mfma_f32_32x32x16_bf16(kf[0],qr[0],zc,0,0,0), P0[2],P0[3],P0[4],P0[5],     pw0[0]=PKW(P0,0), pw0[1]=PKW(P0,2), pw0); \
    LOADCB(t,1); SBAR(); GAPA(C1=__builtin_amdgcn_mfma_f32_32x32x16_bf16(kf[1],qr[0],zc,0,0,0), P0[6],P0[7],P0[8],P0[9],     pw0[2]=PKW(P0,4), pw0[3]=PKW(P0,6), pw0); \
    GAPA(C0=__builtin_amdgcn_mfma_f32_32x32x16_bf16(kf[2],qr[1],C0,0,0,0),   P0[10],P0[11],P0[12],P0[13], pw1[0]=PKW(P0,8), pw1[1]=PKW(P0,10), pw1); \
    GAPA(C1=__builtin_amdgcn_mfma_f32_32x32x16_bf16(kf[3],qr[1],C1,0,0,0),   P0[14],P0[15],P1[0],P1[1],   pw1[2]=PKW(P0,12),pw1[3]=PKW(P0,14), pw1); \
    GAPA(C0=__builtin_amdgcn_mfma_f32_32x32x16_bf16(kf[4],qr[2],C0,0,0,0),   P1[2],P1[3],P1[4],P1[5],     pw2[0]=PKW(P1,0), pw2[1]=PKW(P1,2), pw2); \
    GAPA(C1=__builtin_amdgcn_mfma_f32_32x32x16_bf16(kf[5],qr[2],C1,0,0,0),   P1[6],P1[7],P1[8],P1[9],     pw2[2]=PKW(P1,4), pw2[3]=PKW(P1,6), pw2); \
    GAPA(C0=__builtin_amdgcn_mfma_f32_32x32x16_bf16(kf[6],qr[3],C0,0,0,0),   P1[10],P1[11],P1[12],P1[13], pw3[0]=PKW(P1,8), pw3[1]=PKW(P1,10), pw3); \
    GAPA(C1=__builtin_amdgcn_mfma_f32_32x32x16_bf16(kf[7],qr[3],C1,0,0,0),   P1[14],P1[15],0.f,0.f,       pw3[2]=PKW(P1,12),pw3[3]=PKW(P1,14), pw3); \
    if(!KN)l_reg+=sacc; \
    if(GK){DMA_K((t)+3,sl_cur);} if(GV){DMA_V((t)+1,sl_next);} \
    SBAR(); fl[0]=vtr(vp_+0); fh[0]=vtr(vp_+512); fl[1]=vtr(vp_+4096); fh[1]=vtr(vp_+4608); SBAR(); \
    CMASK(C0,C1,t); \
    if(!KN){ float a=MX3(C0[0],C0[1],C1[0]),b=MX3(C0[2],C0[3],C1[1]); a=MX3(a,C1[2],C1[3]); \
      _Pragma("unroll") for(int r=4;r<16;r+=4){a=MX3(a,C0[r],C0[r+1]);b=MX3(b,C0[r+2],C0[r+3]);a=MX3(a,C1[r],C1[r+1]);b=MX3(b,C1[r+2],C1[r+3]);} \
      float rm=__builtin_fmaxf(a,b); { auto rr=__builtin_amdgcn_permlane32_swap(__float_as_uint(rm),__float_as_uint(rm),false,false); rm=__builtin_fmaxf(__uint_as_float(rr[0]),__uint_as_float(rr[1])); } \
      resc=false; rm-=mhat; \
      if(__builtin_expect(__any(rm>(float)THRL),0)){ const float dl=__builtin_fmaxf(rm,0.f); mhat+=dl; \
        const float f=__builtin_amdgcn_exp2f(-dl); l_reg*=f; if(hi==0)wsf[r32]=f; resc=true; } } \
    SBAR(); \
    GAPB(o[0]=__builtin_amdgcn_mfma_f32_32x32x16_bf16(PAF(0),(bf16x8){fl[0][0],fl[0][1],fl[0][2],fl[0][3],fh[0][0],fh[0][1],fh[0][2],fh[0][3]},o[0],0,0,0), C0,0); fl[2]=vtr(vp_+1024); fh[2]=vtr(vp_+1536); SBAR(); \
    GAPB(o[1]=__builtin_amdgcn_mfma_f32_32x32x16_bf16(PAF(0),(bf16x8){fl[1][0],fl[1][1],fl[1][2],fl[1][3],fh[1][0],fh[1][1],fh[1][2],fh[1][3]},o[1],0,0,0), C0,4); fl[3]=vtr(vp_+5120); fh[3]=vtr(vp_+5632); SBAR(); \
    KRD(GL,0); GAPB(o[0]=__builtin_amdgcn_mfma_f32_32x32x16_bf16(PAF(1),(bf16x8){fl[2][0],fl[2][1],fl[2][2],fl[2][3],fh[2][0],fh[2][1],fh[2][2],fh[2][3]},o[0],0,0,0), C0,8); fl[0]=vtr(vp_+2048); fh[0]=vtr(vp_+2560); SBAR(); \
    KRD(GL,1); GAPB(o[1]=__builtin_amdgcn_mfma_f32_32x32x16_bf16(PAF(1),(bf16x8){fl[3][0],fl[3][1],fl[3][2],fl[3][3],fh[3][0],fh[3][1],fh[3][2],fh[3][3]},o[1],0,0,0), C0,12); fl[1]=vtr(vp_+6144); fh[1]=vtr(vp_+6656); SBAR(); \
    KRD(GL,2); GAPB(o[0]=__builtin_amdgcn_mfma_f32_32x32x16_bf16(PAF(2),(bf16x8){fl[0][0],fl[0][1],fl[0][2],fl[0][3],fh[0][0],fh[0][1],fh[0][2],fh[0][3]},o[0],0,0,0), C1,0); fl[2]=vtr(vp_+3072); fh[2]=vtr(vp_+3584); SBAR(); \
    KRD(GL,3); GAPB(o[1]=__builtin_amdgcn_mfma_f32_32x32x16_bf16(PAF(2),(bf16x8){fl[1][0],fl[1][1],fl[1][2],fl[1][3],fh[1][0],fh[1][1],fh[1][2],fh[1][3]},o[1],0,0,0), C1,4); fl[3]=vtr(vp_+7168); fh[3]=vtr(vp_+7680); SBAR(); \
    GAPB(o[0]=__builtin_amdgcn_mfma_f32_32x32x16_bf16(PAF(3),(bf16x8){fl[2][0],fl[2][1],fl[2][2],fl[2][3],fh[2][0],fh[2][1],fh[2][2],fh[2][3]},o[0],0,0,0), C1,8); fl[0]=vtr(vp2_+0); fh[0]=vtr(vp2_+512); SBAR(); \
    GAPB(o[1]=__builtin_amdgcn_mfma_f32_32x32x16_bf16(PAF(3),(bf16x8){fl[3][0],fl[3][1],fl[3][2],fl[3][3],fh[3][0],fh[3][1],fh[3][2],fh[3][3]},o[1],0,0,0), C1,12); fl[1]=vtr(vp2_+4096); fh[1]=vtr(vp2_+4608); SBAR(); \
    o[2]=__builtin_amdgcn_mfma_f32_32x32x16_bf16(PAF(0),(bf16x8){fl[0][0],fl[0][1],fl[0][2],fl[0][3],fh[0][0],fh[0][1],fh[0][2],fh[0][3]},o[2],0,0,0); SBAR(); fl[2]=vtr(vp2_+1024); fh[2]=vtr(vp2_+1536); SBAR(); \
    o[3]=__builtin_amdgcn_mfma_f32_32x32x16_bf16(PAF(0),(bf16x8){fl[1][0],fl[1][1],fl[1][2],fl[1][3],fh[1][0],fh[1][1],fh[1][2],fh[1][3]},o[3],0,0,0); SBAR(); fl[3]=vtr(vp2_+5120); fh[3]=vtr(vp2_+5632); SBAR(); \
    o[2]=__builtin_amdgcn_mfma_f32_32x32x16_bf16(PAF(1),(bf16x8){fl[2][0],fl[2][1],fl[2][2],fl[2][3],fh[2][0],fh[2][1],fh[2][2],fh[2][3]},o[2],0,0,0); SBAR(); fl[0]=vtr(vp2_+2048); fh[0]=vtr(vp2_+2560); SBAR(); \
    o[3]=__builtin_amdgcn_mfma_f32_32x32x16_bf16(PAF(1),(bf16x8){fl[3][0],fl[3][1],fl[3][2],fl[3][3],fh[3][0],fh[3][1],fh[3][2],fh[3][3]},o[3],0,0,0); SBAR(); fl[1]=vtr(vp2_+6144); fh[1]=vtr(vp2_+6656); SBAR(); \
    o[2]=__builtin_amdgcn_mfma_f32_32x32x16_bf16(PAF(2),(bf16x8){fl[0][0],fl[0][1],fl[0][2],fl[0][3],fh[0][0],fh[0][1],fh[0][2],fh[0][3]},o[2],0,0,0); SBAR(); fl[2]=vtr(vp2_+3072); fh[2]=vtr(vp2_+3584); SBAR(); \
    o[3]=__builtin_amdgcn_mfma_f32_32x32x16_bf16(PAF(2),(bf16x8){fl[1][0],fl[1][1],fl[1][2],fl[1][3],fh[1][0],fh[1][1],fh[1][2],fh[1][3]},o[3],0,0,0); SBAR(); fl[3]=vtr(vp2_+7168); fh[3]=vtr(vp2_+7680); SBAR(); \
    o[2]=__builtin_amdgcn_mfma_f32_32x32x16_bf16(PAF(3),(bf16x8){fl[2][0],fl[2][1],fl[2][2],fl[2][3],fh[2][0],fh[2][1],fh[2][2],fh[2][3]},o[2],0,0,0); SBAR(); \
    o[3]=__builtin_amdgcn_mfma_f32_32x32x16_bf16(PAF(3),(bf16x8){fl[3][0],fl[3][1],fl[3][2],fl[3][3],fh[3][0],fh[3][1],fh[3][2],fh[3][3]},o[3],0,0,0); SBAR(); \
    }while(0)
  int t=1;
  #undef CMASK
  #define CMASK(P0,P1,t) do{}while(0)
  for(;t+5<NT;t+=2){
    STEP(pB0,pB1,pA0,pA1,t,true,true,true);     WAIT_BAR(3); RESC(); ROT();
    STEP(pA0,pA1,pB0,pB1,t+1,true,true,true);   WAIT_BAR(3); RESC(); ROT();
  }
  #undef CMASK
  #define CMASK(P0,P1,t) do{int jb_=(t)-(NT-4); if(jb_>=0){ if(FOX)cmask(P0,P1,jb_,qrel,hi); else if(jb_>(wid>>1))mask_all(P0,P1);} }while(0)
  #define ENDW(tt) do{ if((tt)+3<NT){WAIT_BAR(3);} else if((tt)+2<NT){WAIT_BAR(2);} else {WAIT_BAR(0);} }while(0)
  for(;t+3<NT;t+=2){
    STEP(pB0,pB1,pA0,pA1,t,(t+3<NT),(t+1<NT),(t+1<NT));       ENDW(t);   RESC(); ROT();
    STEP(pA0,pA1,pB0,pB1,t+1,(t+4<NT),(t+2<NT),(t+2<NT));     ENDW(t+1); RESC(); ROT();
  }
  STEP(pB0,pB1,pA0,pA1,t,(t+3<NT),(t+1<NT),(t+1<NT));         ENDW(t);   RESC(); ROT();
  STEP(pA0,pA1,pB0,pB1,NT-1,false,false,false); RESC();
  { float sacc=pA0[0]+pA0[1]; _Pragma("unroll") for(int r=2;r<16;++r)sacc+=pA0[r]; _Pragma("unroll") for(int r=0;r<16;++r)sacc+=pA1[r]; if(!KN)l_reg+=sacc;
    pw0=(u32x4){PKW(pA0,0),PKW(pA0,2),PKW(pA0,4),PKW(pA0,6)};pw1=(u32x4){PKW(pA0,8),PKW(pA0,10),PKW(pA0,12),PKW(pA0,14)};pw2=(u32x4){PKW(pA1,0),PKW(pA1,2),PKW(pA1,4),PKW(pA1,6)};pw3=(u32x4){PKW(pA1,8),PKW(pA1,10),PKW(pA1,12),PKW(pA1,14)};
    SBAR(); pv(o,vb0+sl_cur,PAF(0),PAF(1),PAF(2),PAF(3)); pv(o+2,vb0b+sl_cur,PAF(0),PAF(1),PAF(2),PAF(3)); }
  #undef PKW
  #undef PAF
  #undef PIN
  #undef MX3
  #undef GAPA
  #undef GAPB
  #undef EX
  #undef KRD
  #undef STEP
  #undef ENDW
  if(!KN){auto rr=__builtin_amdgcn_permlane32_swap(__float_as_uint(l_reg),__float_as_uint(l_reg),false,false);l_reg=__uint_as_float(rr[0])+__uint_as_float(rr[1]); if(!FOX&&hi==0){stw[r32]=mhat;stw[32+r32]=l_reg;} }
  if(hi==0)wsf[32+r32]=l_reg;asm volatile("s_waitcnt lgkmcnt(0)":::"memory");
  float rli[16];
  #pragma unroll
  for(int r=0;r<16;++r)rli[r]=__builtin_amdgcn_rcpf(wsf[32+crow(r,hi)]);
  bf16*Ow=Ob+(long)(wid*QBLK)*OP;
  { bf16*stg=(bf16*)(shm+LDS_OST)+wid*2048;
    #pragma unroll
    for(int hv=0;hv<2;++hv){
    #pragma unroll
    for(int r=0;r<16;++r){const int orow=crow(r,hi);
      #pragma unroll
      for(int d0=0;d0<2;++d0)stg[orow*64+d0*32+r32]=__float2bfloat16(o[2*hv+d0][r]*rli[r]);}
    asm volatile("s_waitcnt lgkmcnt(0)":::"memory");
    #pragma unroll
    for(int i=0;i<4;++i){const int row=i*8+(lane>>3),ch=lane&7; const u32x4 v=*(const u32x4*)(stg+row*64+ch*8); ATTN_STORE16(Ow+(long)row*OP+hv*64+ch*8,v);}
    asm volatile("s_waitcnt lgkmcnt(0)":::"memory"); } }
  asm volatile("s_waitcnt lgkmcnt(0)\n\ts_barrier":::"memory");
  #undef DMA_K
  #undef TROW
  #undef LOADCB
  #undef ADDB
  #undef DMA_V
  #undef CMASK
  #undef START
  #undef RESC
  #undef ROT
}
#undef SBAR
#undef WAIT_BAR
}
constexpr int NWAVES = 8;
constexpr int NB = 16, SEQ = 2048, DM_ = 1024, MROWS = NB * SEQ, NMETA = 16;
constexpr int INC = 5128, DK_OFF = 512, DV_OFF = 1024, FK_OFF = 2048, FV_OFF = 2560, FF_OFF = 3072;
constexpr int KROWS = pg8::KROWS;
constexpr float LOG2E = 1.4426950408889634f;
constexpr int N_PHASES = 12;
constexpr float SC_X = 16.f, SC_W = 256.f, SC_M = 32.f, SC_H = 16.f, SC_A = 16.f;

constexpr int RING_OFF = 0, RING_BYTES = 131072;
constexpr int LDSCTL_OFF = RING_BYTES, MISC_OFF = LDSCTL_OFF + 320;
constexpr int EPI_TAB_OFF = RING_BYTES + 1024;
constexpr int LDS_BYTES = 147456;

#define GAS __attribute__((address_space(1)))
#define LAS __attribute__((address_space(3)))
typedef unsigned short bf16;
typedef unsigned v4u __attribute__((ext_vector_type(4)));
typedef unsigned v2u __attribute__((ext_vector_type(2)));
typedef float f32x4 __attribute__((ext_vector_type(4)));
typedef GAS unsigned gu32;
typedef short bf16x8 __attribute__((ext_vector_type(8)));
#define RLX_AGENT __ATOMIC_RELAXED, __HIP_MEMORY_SCOPE_AGENT
#define LDS_WAIT() asm volatile("s_waitcnt lgkmcnt(0)" ::: "memory")
#define VM_WAIT() asm volatile("s_waitcnt vmcnt(0)" ::: "memory")
__device__ __forceinline__ unsigned pk2(float lo, float hi) { return pg8::cvt_pk_bf16(lo, hi); }


#define XB_TMO      128
#define XB_XCNT(j)  (256  + 64 * (j))
#define XB_XSUB(j)  (1280 + 64 * (j))
#define XB_XGEN(j)  (2304 + 64 * (j))
#define XB_TOP      3328
#define XB_TOPGEN   3392
#define XCD_BAR_WORDS 3456
#define XB_SPIN_CAP (1u << 18)

__device__ __forceinline__ unsigned xb_ld(unsigned* p)              { return __hip_atomic_load(p, __ATOMIC_RELAXED, __HIP_MEMORY_SCOPE_AGENT); }
__device__ __forceinline__ unsigned xb_add(unsigned* p, unsigned v) { return __hip_atomic_fetch_add(p, v, __ATOMIC_RELAXED, __HIP_MEMORY_SCOPE_AGENT); }
__device__ __forceinline__ unsigned xb_xcc_id() { return (unsigned)__builtin_amdgcn_s_getreg((3 << 11) | 20) & 0xFu; }
#define XB_SPIN(cond, bar) do { unsigned _sp = 0; while (cond) { __builtin_amdgcn_s_sleep(1); \
    if ((++_sp & 255u) == 0u) { if (xb_ld(&(bar)[XB_TMO])) break; if (_sp > XB_SPIN_CAP) { atomicAdd(&(bar)[XB_TMO], 1u); break; } } } } while (0)

struct XcdBarrier {
    unsigned* bar; unsigned x; int wv;
    volatile LAS unsigned* st;
};

__device__ __forceinline__ XcdBarrier xcd_barrier_post(unsigned* bar, volatile LAS unsigned* st) {
    XcdBarrier b; b.bar = bar; b.x = xb_xcc_id(); b.st = st;
    if (threadIdx.x == 0) st[2] = xb_add(&bar[XB_XCNT(b.x)], 1u);
    return b;
}
__device__ __forceinline__ void xcd_barrier_complete(unsigned* bar, unsigned x, unsigned& nloc, unsigned& nx) {
    const unsigned G = gridDim.x * gridDim.y * gridDim.z;
    unsigned sum, cnt, mine, sp = 0u;
    for (;;) {
        sum = 0u; cnt = 0u; mine = 0u;
#pragma unroll
        for (unsigned j = 0; j < 16; ++j) { const unsigned c = xb_ld(&bar[XB_XCNT(j)]); sum += c; cnt += (c > 0u) ? 1u : 0u; mine = (j == x) ? c : mine; }
        if (sum == G) break;
        __builtin_amdgcn_s_sleep(1);
        if ((++sp & 255u) == 0u) { if (xb_ld(&bar[XB_TMO])) break; if (sp > XB_SPIN_CAP) { atomicAdd(&bar[XB_TMO], 1u); break; } }
    }
    nloc = mine > 0u ? mine : 1u; nx = cnt > 0u ? cnt : 1u;
}

__device__ __forceinline__ void xcd_barrier(const XcdBarrier& b) {
    asm volatile("s_waitcnt vmcnt(0)" ::: "memory");
    __syncthreads();
    if (b.wv == 0 && mk_lane() == 0) {
        unsigned* bar = b.bar;
        __builtin_amdgcn_s_waitcnt(0);
        unsigned nloc = b.st[0], nx = b.st[1];
        if (nloc == 0u) { xcd_barrier_complete(bar, b.x, nloc, nx); b.st[0] = nloc; b.st[1] = nx;
            unsigned dense = 0u; for (unsigned j = 0; j < 16; ++j) if (j < b.x && xb_ld(&bar[XB_XCNT(j)]) > 0u) ++dense; b.st[3] = dense; }
        const unsigned old = xb_add(&bar[XB_XSUB(b.x)], 1u);
        const unsigned gen = old / nloc;
        if (old + 1u == (gen + 1u) * nloc) {
            __builtin_amdgcn_fence(__ATOMIC_RELEASE, "agent");
            asm volatile("s_waitcnt vmcnt(0)" ::: "memory");
            const unsigned og = xb_add(&bar[XB_TOP], 1u);
            const unsigned tg = og / nx;
            if (og + 1u == (tg + 1u) * nx) xb_add(&bar[XB_TOPGEN], 1u);
            else XB_SPIN(xb_ld(&bar[XB_TOPGEN]) == tg, bar);
            __builtin_amdgcn_fence(__ATOMIC_ACQUIRE, "agent");
            xb_add(&bar[XB_XGEN(b.x)], 1u);
            asm volatile("s_waitcnt vmcnt(0)" ::: "memory");
        } else {
            XB_SPIN(xb_ld(&bar[XB_XGEN(b.x)]) == gen, bar);
            __builtin_amdgcn_fence(__ATOMIC_ACQUIRE, "agent");
            asm volatile("s_waitcnt vmcnt(0)" ::: "memory");
        }
    }
    __syncthreads();
}


struct Frame {
    LAS unsigned char* lds;
    volatile LAS unsigned* MISC;
    gu32* ctl;
    int tid, lane, wave, vcu, G;
    const float *x, *meta, *gmix, *win, *bgate, *bforget, *dqg, *dkg, *dlam, *dsg, *fqg, *fkg, *wbd, *wbf, *wout, *gffn, *wq, *sk, *u, *v;
    float* out;
    unsigned char* ws;
};

template <int CTRL> __device__ __forceinline__ float dppx(float x) { return __builtin_amdgcn_update_dpp(0.f, x, CTRL, 0xf, 0xf, true); }
__device__ __forceinline__ float wave_sum(float v) {
    v += dppx<0xB1>(v); v += dppx<0x4E>(v); v += dppx<0x141>(v); v += dppx<0x128>(v);
    v += __shfl_xor(v, 16); v += __shfl_xor(v, 32);
    return v;
}
__device__ __forceinline__ float log_sigmoid(float z) { return -0.6931471805599453f * __builtin_amdgcn_logf(1.0f + __builtin_amdgcn_exp2f(-LOG2E * z)); }

__device__ __forceinline__ void p0_transpose_item(const float* W, int N, int nin0, const float* ks, bf16* WT, int K, int nout0, int k0, LAS float* scr, int lane) {
#pragma unroll 16
    for (int i = 0; i < 32; ++i) { const int kk = 2 * i + (lane >> 5); float w = W[(size_t)(k0 + kk) * N + nin0 + (lane & 31)]; if (ks) w *= ks[k0 + kk]; scr[kk * 33 + (lane & 31)] = w; }
    LDS_WAIT(); asm volatile("" ::: "memory");
    const int c = lane & 7;
#pragma unroll
    for (int j = 0; j < 4; ++j) { const int n = (lane >> 3) + 8 * j; const LAS float* s = scr + (8 * c) * 33 + n;
        v4u o; o.x = pk2(s[0 * 33], s[1 * 33]); o.y = pk2(s[2 * 33], s[3 * 33]); o.z = pk2(s[4 * 33], s[5 * 33]); o.w = pk2(s[6 * 33], s[7 * 33]);
        *(GAS v4u*)(WT + (size_t)(nout0 + n) * K + k0 + 8 * c) = o; }
    LDS_WAIT(); asm volatile("" ::: "memory");
}
__device__ __forceinline__ void p0_transpose8_item(const float* W, int N, int nin0, const float* ks, float scale, unsigned char* WT8, int K, int nout0, int k0, LAS float* scr, int lane) {
#pragma unroll 16
    for (int i = 0; i < 32; ++i) { const int kk = 2 * i + (lane >> 5); float w = W[(size_t)(k0 + kk) * N + nin0 + (lane & 31)] * scale; if (ks) w *= ks[k0 + kk]; scr[kk * 33 + (lane & 31)] = w; }
    LDS_WAIT(); asm volatile("" ::: "memory");
#pragma unroll
    for (int j = 0; j < 2; ++j) { const int task = lane + 64 * j, n = task >> 2, c = task & 3; const LAS float* s = scr + (16 * c) * 33 + n;
        v4u o; o.x = pg8::cvt_pk4_fp8(s[0 * 33], s[1 * 33], s[2 * 33], s[3 * 33]); o.y = pg8::cvt_pk4_fp8(s[4 * 33], s[5 * 33], s[6 * 33], s[7 * 33]);
        o.z = pg8::cvt_pk4_fp8(s[8 * 33], s[9 * 33], s[10 * 33], s[11 * 33]); o.w = pg8::cvt_pk4_fp8(s[12 * 33], s[13 * 33], s[14 * 33], s[15 * 33]);
        *(GAS v4u*)(WT8 + (size_t)(nout0 + n) * K + k0 + 16 * c) = o; }
    LDS_WAIT(); asm volatile("" ::: "memory");
}
__device__ __forceinline__ void p0_cvt_row(const float* src, bf16* dst, const float* cs, int lane) {
    const GAS f32x4* xr = (const GAS f32x4*)src + lane; GAS v2u* o8 = (GAS v2u*)dst + lane;
#pragma unroll
    for (int j = 0; j < 4; ++j) { f32x4 v = xr[64 * j]; if (cs) v = v * ((const GAS f32x4*)cs)[lane + 64 * j]; v2u w; w.x = pk2(v.x, v.y); w.y = pk2(v.z, v.w); o8[64 * j] = w; }
}

__device__ __forceinline__ void p0_meta(Frame& F, int j) {
    LAS float* hm = (LAS float*)F.lds;
    LAS float* red = hm + 16384;
    LAS float* res = red + 8192;
    const int tid = F.tid, lane = F.lane, wave = F.wave;
    for (int rr = 0; rr < 2; ++rr) {
        const int r = 2 * wave + rr; const GAS f32x4* mr = (const GAS f32x4*)(F.meta + (size_t)r * 1024) + lane;
        f32x4 v[4]; float ss = 0.f;
#pragma unroll
        for (int q = 0; q < 4; ++q) { v[q] = mr[64 * q]; ss += (v[q].x * v[q].x + v[q].y * v[q].y) + (v[q].z * v[q].z + v[q].w * v[q].w); }
        const float rs = 1.0f / sqrtf(wave_sum(ss) * (1.0f / 1024.0f) + 1e-6f);
#pragma unroll
        for (int q = 0; q < 4; ++q) { const int k = 4 * lane + 256 * q; const f32x4 g = ((const GAS f32x4*)F.gmix)[lane + 64 * q];
            hm[(k + 0) * 16 + r] = v[q].x * rs * g.x; hm[(k + 1) * 16 + r] = v[q].y * rs * g.y; hm[(k + 2) * 16 + r] = v[q].z * rs * g.z; hm[(k + 3) * 16 + r] = v[q].w * rs * g.w; }
    }
    __syncthreads();
    const int kind = j >> 3, gi = j & 7;
    const int c = tid & 63, s = tid >> 6;
    int col_in;
    if (kind == 0) col_in = DK_OFF + gi * 64 + c; else if (kind == 1) col_in = DV_OFF + gi * 64 + c; else if (kind == 2) col_in = FK_OFF + gi * 64 + c; else if (kind == 3) col_in = FV_OFF + gi * 64 + c; else col_in = FF_OFF + (c & 7);
    float acc[16];
#pragma unroll
    for (int r = 0; r < 16; ++r) acc[r] = 0.f;
    for (int k0 = 128 * s; k0 < 128 * s + 128; k0 += 64) {
        float wl[64];
#pragma unroll
        for (int u = 0; u < 64; ++u) wl[u] = F.win[(size_t)(k0 + u) * INC + col_in];
#pragma unroll
        for (int u = 0; u < 64; ++u) { const int k = k0 + u; const float w = wl[u];
        const LAS f32x4* hp = (const LAS f32x4*)(hm + k * 16);
        const f32x4 h0 = hp[0], h1 = hp[1], h2 = hp[2], h3 = hp[3];
        acc[0] += h0.x * w; acc[1] += h0.y * w; acc[2] += h0.z * w; acc[3] += h0.w * w; acc[4] += h1.x * w; acc[5] += h1.y * w; acc[6] += h1.z * w; acc[7] += h1.w * w;
        acc[8] += h2.x * w; acc[9] += h2.y * w; acc[10] += h2.z * w; acc[11] += h2.w * w; acc[12] += h3.x * w; acc[13] += h3.y * w; acc[14] += h3.z * w; acc[15] += h3.w * w;
        } }
#pragma unroll
    for (int r = 0; r < 16; ++r) red[(s * 16 + r) * 64 + c] = acc[r];
    __syncthreads();
    for (int o = tid; o < 1024; o += 512) { float t = 0.f;
#pragma unroll
        for (int q = 0; q < 8; ++q) t += red[q * 1024 + o];
        res[o] = t; }
    __syncthreads();
    const int r = tid >> 5, dlo = tid & 31;
    if (kind == 4) {
        if (dlo < 8) ((GAS float*)(F.ws + WS_LOGFM))[r * 8 + dlo] = log_sigmoid(res[r * 64 + dlo] + F.bforget[dlo]);
    } else {
        float y0 = res[r * 64 + dlo], y1 = res[r * 64 + dlo + 32];
        if (kind == 0 || kind == 2) {
            float ss = 0.f;
            for (int d = 0; d < 64; ++d) { const float t = res[r * 64 + d]; ss += t * t; }
            const float rs = 1.0f / sqrtf(ss * (1.0f / 64.0f) + 1e-6f);
            float g0, g1; if (kind == 0) { g0 = F.dkg[dlo]; g1 = F.dkg[dlo + 32]; } else { g0 = F.fkg[dlo]; g1 = F.fkg[dlo + 32]; }
            y0 *= rs * g0; y1 *= rs * g1;
            if (kind == 0) {
                const float invf = __builtin_amdgcn_exp2f(-(float)dlo * (13.287712379549449f / 32.0f));
                float rev = (float)r * invf * 0.15915494309189535f; rev = __builtin_amdgcn_fractf(rev);
                const float cs = __builtin_amdgcn_cosf(rev), sn = __builtin_amdgcn_sinf(rev);
                const float x1 = y0, x2 = y1; y0 = x1 * cs - x2 * sn; y1 = x2 * cs + x1 * sn;
            }
        }
        bf16* outp = (bf16*)(F.ws + (kind == 0 ? WS_DK : kind == 1 ? WS_DV : kind == 2 ? WS_FK : WS_FV));
        const unsigned short b0 = (unsigned short)(pk2(y0, 0.f) & 0xffffu), b1 = (unsigned short)(pk2(y1, 0.f) & 0xffffu);
        for (int b = 0; b < NB; ++b) { bf16* p = outp + ((size_t)b * KROWS + 2048 + r) * 512 + gi * 64; p[dlo] = b0; p[dlo + 32] = b1; }
        for (int o = tid; o < NB * 48 * 8; o += 512) { const int b = o / 384, rem = o % 384, pr = rem >> 3, ch = rem & 7;
            *(GAS v4u*)(outp + ((size_t)b * KROWS + 2064 + pr) * 512 + gi * 64 + ch * 8) = (v4u){0u, 0u, 0u, 0u}; }
    }
    __syncthreads();
}

struct P0Item { const float* W; const float* ks; unsigned char* WT; int N, nin0, K, nout0, k0; float scale; bool f8; };
__device__ __forceinline__ P0Item p0_item(Frame& F, int it) {
    constexpr int I_IN = 16 * 160, I_BD = 8 * 32, I_BF = 8 * 32, I_OUT = 16 * 32;
    P0Item d; int r = it;
    if (r < I_IN) { const int kb = r / 160, ob = r % 160, pn = ob >> 3, blk = ob & 7;
        const bool perm = true;
        const int L0 = perm ? (256 * pn + 64 * (blk & 3) + 32 * (blk >> 2)) : (256 * pn + 32 * blk);
        d.W = F.win; d.ks = F.gmix; d.WT = F.ws + WS_WIN; d.N = INC; d.nin0 = L0 + (L0 >= 3072 ? 8 : 0); d.K = 1024; d.nout0 = 32 * ob; d.k0 = 64 * kb; d.scale = SC_W; d.f8 = true; return d; }
    r -= I_IN;
    if (r < I_BD) { d.W = F.wbd; d.ks = nullptr; d.WT = F.ws + WS_WBD; d.N = 1024; d.nin0 = 32 * (r % 32); d.K = 512; d.nout0 = 32 * (r % 32); d.k0 = 64 * (r / 32); d.scale = SC_W; d.f8 = true; return d; }
    r -= I_BD;
    if (r < I_BF) { d.W = F.wbf; d.ks = nullptr; d.WT = F.ws + WS_WBF; d.N = 1024; d.nin0 = 32 * (r % 32); d.K = 512; d.nout0 = 32 * (r % 32); d.k0 = 64 * (r / 32); d.scale = SC_W; d.f8 = true; return d; }
    r -= I_BF;
    if (r < I_OUT) { d.W = F.wout; d.ks = nullptr; d.WT = F.ws + WS_WOUT; d.N = 1024; d.nin0 = 32 * (r % 32); d.K = 1024; d.nout0 = 32 * (r % 32); d.k0 = 64 * (r / 32); d.scale = SC_W; d.f8 = true; return d; }
    r -= I_OUT;
    { const int ob = r % 64, blk = ob & 7; d.nin0 = 256 * (ob >> 3) + 64 * (blk & 3) + 32 * (blk >> 2); }
    d.W = F.wq; d.ks = F.gffn; d.WT = F.ws + WS_WQ; d.N = 2048; d.K = 1024; d.nout0 = 32 * (r % 64); d.k0 = 64 * (r / 64); d.scale = 1.0f; d.f8 = false; return d;
}
__device__ __forceinline__ void p0_item_load(const P0Item& d, float (&w)[32], int lane) {
#pragma unroll
    for (int i = 0; i < 32; ++i) { const int kk = 2 * i + (lane >> 5); w[i] = d.W[(size_t)(d.k0 + kk) * d.N + d.nin0 + (lane & 31)] * d.scale; if (d.ks) w[i] *= d.ks[d.k0 + kk]; }
}
__device__ __forceinline__ void p0_item_store(const P0Item& d, const float (&w)[32], LAS float* scr, int lane) {
#pragma unroll
    for (int i = 0; i < 32; ++i) { const int kk = 2 * i + (lane >> 5); scr[kk * 33 + (lane & 31)] = w[i]; }
    LDS_WAIT(); asm volatile("" ::: "memory");
    if (d.f8) {
#pragma unroll
        for (int j = 0; j < 2; ++j) { const int task = lane + 64 * j, n = task >> 2, c = task & 3; const LAS float* s = scr + (16 * c) * 33 + n;
            v4u o; o.x = pg8::cvt_pk4_fp8(s[0 * 33], s[1 * 33], s[2 * 33], s[3 * 33]); o.y = pg8::cvt_pk4_fp8(s[4 * 33], s[5 * 33], s[6 * 33], s[7 * 33]);
            o.z = pg8::cvt_pk4_fp8(s[8 * 33], s[9 * 33], s[10 * 33], s[11 * 33]); o.w = pg8::cvt_pk4_fp8(s[12 * 33], s[13 * 33], s[14 * 33], s[15 * 33]);
            *(GAS v4u*)(d.WT + (size_t)(d.nout0 + n) * d.K + d.k0 + 16 * c) = o; }
    } else {
        const int c = lane & 7;
#pragma unroll
        for (int j = 0; j < 4; ++j) { const int n = (lane >> 3) + 8 * j; const LAS float* s = scr + (8 * c) * 33 + n;
            v4u o; o.x = pk2(s[0 * 33], s[1 * 33]); o.y = pk2(s[2 * 33], s[3 * 33]); o.z = pk2(s[4 * 33], s[5 * 33]); o.w = pk2(s[6 * 33], s[7 * 33]);
            *(GAS v4u*)((bf16*)d.WT + (size_t)(d.nout0 + n) * d.K + d.k0 + 8 * c) = o; }
    }
    LDS_WAIT(); asm volatile("" ::: "memory");
}
__device__ __forceinline__ void p0_sec_transposes(Frame& F) {
    LAS float* scr = (LAS float*)(F.lds + RING_OFF + F.wave * 8704);
    const int gw = F.vcu * NWAVES + F.wave, NGW = F.G * NWAVES, lane = F.lane;
    constexpr int NITEMS = 16 * 160 + 8 * 32 + 8 * 32 + 16 * 32 + 16 * 64;
    const int it1 = gw + NGW, it2 = gw + 2 * NGW;
    const P0Item d0 = p0_item(F, gw), d1 = p0_item(F, it1 < NITEMS ? it1 : gw), d2 = p0_item(F, it2 < NITEMS ? it2 : gw);
    float w0[32], w1[32], w2[32];
    p0_item_load(d0, w0, lane);
    if (it1 < NITEMS) p0_item_load(d1, w1, lane);
    if (it2 < NITEMS) p0_item_load(d2, w2, lane);
    p0_item_store(d0, w0, scr, lane);
    if (it1 < NITEMS) p0_item_store(d1, w1, scr, lane);
    if (it2 < NITEMS) p0_item_store(d2, w2, scr, lane);
    for (int it = gw + 3 * NGW; it < NITEMS; it += NGW) { const P0Item d = p0_item(F, it); float w[32]; p0_item_load(d, w, lane); p0_item_store(d, w, scr, lane); }
}
__device__ __forceinline__ void p0_sec_tables(Frame& F) {
    const int gw = F.vcu * NWAVES + F.wave, NGW = F.G * NWAVES, lane = F.lane;
    for (int it = gw; it < 256; it += NGW) p0_cvt_row(F.sk + (size_t)it * 1024, (bf16*)(F.ws + WS_SK) + (size_t)it * 1024, nullptr, lane);
    {
        f32x4 gsc[4];
#pragma unroll
        for (int j = 0; j < 4; ++j) gsc[j] = ((const GAS f32x4*)F.gffn)[lane + 64 * j] * 508.0f;
        for (int it = gw; it < 8192; it += NGW) {
            const bool isu = it < 4096; const int e0 = (isu ? it : it - 4096) * 4;
            const float* src = isu ? F.u : F.v;
            f32x4 v[4][4];
#pragma unroll
            for (int r = 0; r < 4; ++r)
#pragma unroll
                for (int j = 0; j < 4; ++j) v[r][j] = ((const GAS f32x4*)(src + (size_t)(e0 + r) * 1024))[lane + 64 * j];
            unsigned char* dst = F.ws + (isu ? WS_US8 : WS_VS8) + (size_t)e0 * 128 + 4 * (lane & 31);
#pragma unroll
            for (int r = 0; r < 4; ++r)
#pragma unroll
                for (int j = 0; j < 4; ++j) { f32x4 t = v[r][j]; unsigned pk;
                    if (isu) { t = t * gsc[j];
                        const int q0 = min(max((int)__builtin_rintf(t.x), -127), 127), q1 = min(max((int)__builtin_rintf(t.y), -127), 127), q2 = min(max((int)__builtin_rintf(t.z), -127), 127), q3 = min(max((int)__builtin_rintf(t.w), -127), 127);
                        pk = (unsigned)(q0 & 255) | ((unsigned)(q1 & 255) << 8) | ((unsigned)(q2 & 255) << 16) | ((unsigned)q3 << 24); }
                    else { t = t * 32.0f; int p = __builtin_amdgcn_cvt_pk_fp8_f32(t.x, t.y, 0, false); p = __builtin_amdgcn_cvt_pk_fp8_f32(t.z, t.w, p, true); pk = (unsigned)p; }
                    *(GAS unsigned*)(dst + (size_t)(2 * j + (lane >> 5)) * 16384 * 128 + r * 128) = pk; }
        }
    }
}
__device__ __forceinline__ void p0_sec_xrows(Frame& F) {
    const int gw = F.vcu * NWAVES + F.wave, NGW = F.G * NWAVES, lane = F.lane;
    {
        float wfr[4][4][8];
#pragma unroll
        for (int q = 0; q < 4; ++q)
#pragma unroll
            for (int e = 0; e < 4; ++e) { const int k = 4 * lane + 256 * q + e; const float g = F.gmix[k]; const GAS f32x4* wp = (const GAS f32x4*)(F.win + (size_t)k * INC + FF_OFF);
                const f32x4 a = wp[0], b = wp[1]; wfr[q][e][0] = a.x * g; wfr[q][e][1] = a.y * g; wfr[q][e][2] = a.z * g; wfr[q][e][3] = a.w * g; wfr[q][e][4] = b.x * g; wfr[q][e][5] = b.y * g; wfr[q][e][6] = b.z * g; wfr[q][e][7] = b.w * g; }
        const float bfl = F.bforget[lane & 7];
        const int xw0 = (F.vcu >= 33 && F.G > 64) ? (F.vcu - 33) * NWAVES + F.wave : (F.G > 64 ? MROWS : gw), XNW = F.G > 64 ? (F.G - 33) * NWAVES : NGW;
        f32x4 vn[4], vn2[4];
#pragma unroll
        for (int q = 0; q < 4; ++q) { vn[q] = ((const GAS f32x4*)(F.x + (size_t)(xw0 < MROWS ? xw0 : 0) * 1024) + lane)[64 * q]; vn2[q] = ((const GAS f32x4*)(F.x + (size_t)(xw0 + XNW < MROWS ? xw0 + XNW : 0) * 1024) + lane)[64 * q]; }
        for (int m = xw0; m < MROWS; m += XNW) {
            f32x4 v[4]; float ss = 0.f;
#pragma unroll
            for (int q = 0; q < 4; ++q) { v[q] = vn[q]; vn[q] = vn2[q]; ss += (v[q].x * v[q].x + v[q].y * v[q].y) + (v[q].z * v[q].z + v[q].w * v[q].w); }
            { const int mn = (m + 2 * XNW < MROWS) ? m + 2 * XNW : m; const GAS f32x4* xn = (const GAS f32x4*)(F.x + (size_t)mn * 1024) + lane;
#pragma unroll
              for (int q = 0; q < 4; ++q) vn2[q] = xn[64 * q]; }
            const float rs = 1.0f / sqrtf(wave_sum(ss) * (1.0f / 1024.0f) + 1e-6f);
            GAS unsigned* o8 = (GAS unsigned*)(F.ws + WS_XB + (size_t)m * 1024) + lane;
            float fl[8];
#pragma unroll
            for (int h = 0; h < 8; ++h) fl[h] = 0.f;
#pragma unroll
            for (int q = 0; q < 4; ++q) { const float r16 = rs * SC_X; o8[64 * q] = pg8::cvt_pk4_fp8(v[q].x * r16, v[q].y * r16, v[q].z * r16, v[q].w * r16);
#pragma unroll
                for (int h = 0; h < 8; ++h) fl[h] += (v[q].x * wfr[q][0][h] + v[q].y * wfr[q][1][h]) + (v[q].z * wfr[q][2][h] + v[q].w * wfr[q][3][h]); }
            float mine = 0.f;
#pragma unroll
            for (int h = 0; h < 8; ++h) { const float t = wave_sum(fl[h]); if ((lane & 7) == h) mine = t; }
            if (lane < 8) ((GAS float*)(F.ws + WS_LOGF))[(size_t)m * 8 + lane] = log_sigmoid(mine * rs + bfl);
        }
    }
}
__device__ __forceinline__ void p0_prologue(Frame& F) {
    if (F.vcu < 33) p0_meta(F, F.vcu);
    if (F.vcu == 33 && F.tid < 256) { const int t = F.tid, w = t >> 6, d = t & 63; float gv; if (w == 0) gv = F.dqg[d]; else if (w == 1) gv = F.dkg[d]; else if (w == 2) gv = F.fqg[d]; else gv = F.fkg[d]; ((GAS float*)(F.ws + WS_GAINS))[t] = gv; }
    if (F.wave & 1) { p0_sec_xrows(F); p0_sec_tables(F); p0_sec_transposes(F); }
    else { p0_sec_transposes(F); p0_sec_tables(F); p0_sec_xrows(F); }
    __syncthreads();
}

__device__ __forceinline__ void p1_cumscan(Frame& F, int bh) {
    LAS float* part = (LAS float*)F.lds;
    const int b = bh >> 3, h = bh & 7, lane = mk_lane(), wave = F.wave, tid = wave * 64 + lane;
    const GAS float* lf = (const GAS float*)(F.ws + WS_LOGF) + (size_t)b * SEQ * 8 + h;
    const GAS float* lfm = (const GAS float*)(F.ws + WS_LOGFM) + h;
    GAS float* cb = (GAS float*)(F.ws + WS_CB) + (size_t)bh * KROWS;
    float cm = 0.f; float lm[16];
#pragma unroll
    for (int m = 0; m < 16; ++m) lm[m] = lfm[m * 8];
#pragma unroll
    for (int m = 0; m < 16; ++m) { cm += lm[m]; if (tid == m) cb[2048 + m] = -cm * LOG2E; }
    if (tid >= 16 && tid < 64) cb[2048 + tid] = 0.f;
    float l0 = lf[(size_t)(4 * tid + 0) * 8], l1 = lf[(size_t)(4 * tid + 1) * 8], l2 = lf[(size_t)(4 * tid + 2) * 8], l3 = lf[(size_t)(4 * tid + 3) * 8];
    l1 += l0; l2 += l1; l3 += l2;
    float incl = l3;
#pragma unroll
    for (int o = 1; o < 64; o <<= 1) { const float t = __shfl_up(incl, o); if (lane >= o) incl += t; }
    if (lane == 63) part[wave] = incl;
    __syncthreads();
    float base = cm;
    for (int w = 0; w < wave; ++w) base += part[w];
    base += incl - l3;
    cb[4 * tid + 0] = -(base + l0) * LOG2E; cb[4 * tid + 1] = -(base + l1) * LOG2E; cb[4 * tid + 2] = -(base + l2) * LOG2E; cb[4 * tid + 3] = -(base + l3) * LOG2E;
    __syncthreads();
}

__device__ __forceinline__ void p2b_combine(Frame& F) {
    const int gw = F.vcu * NWAVES + F.wave, NGW = F.G * NWAVES, lane = mk_lane();
    float s01 = 0.f, s23 = 0.f;
    { const float a = F.dlam[lane], b = F.dlam[64 + lane], c = F.dlam[128 + lane], d = F.dlam[192 + lane]; s01 = wave_sum(a * b); s23 = wave_sum(c * d); }
    const float lam = expf(s01) - expf(s23) + 0.2f;
    const int h = lane >> 4, dch = (lane & 15) * 8;
    float g8[8];
#pragma unroll
    for (int e = 0; e < 8; ++e) g8[e] = F.dsg[dch + e] * 0.8f;
    const bf16* OD = (const bf16*)(F.ws + WS_OD); bf16* YA = (bf16*)(F.ws + WS_YA);
    for (int m = gw; m < MROWS; m += NGW) {
        const v4u a = *(const GAS v4u*)(OD + (size_t)m * 1024 + h * 128 + dch), b = *(const GAS v4u*)(OD + (size_t)m * 1024 + (4 + h) * 128 + dch);
        float od[8] = {pg8::bf_lo(a.x) - lam * pg8::bf_lo(b.x), pg8::bf_hi(a.x) - lam * pg8::bf_hi(b.x), pg8::bf_lo(a.y) - lam * pg8::bf_lo(b.y), pg8::bf_hi(a.y) - lam * pg8::bf_hi(b.y),
                       pg8::bf_lo(a.z) - lam * pg8::bf_lo(b.z), pg8::bf_hi(a.z) - lam * pg8::bf_hi(b.z), pg8::bf_lo(a.w) - lam * pg8::bf_lo(b.w), pg8::bf_hi(a.w) - lam * pg8::bf_hi(b.w)};
        float ss = 0.f;
#pragma unroll
        for (int e = 0; e < 8; ++e) ss += od[e] * od[e];
        ss += __shfl_xor(ss, 1); ss += __shfl_xor(ss, 2); ss += __shfl_xor(ss, 4); ss += __shfl_xor(ss, 8);
        const float rs = 1.0f / sqrtf(ss * (1.0f / 128.0f) + 1e-6f);
        v4u w; w.x = pk2(od[0] * rs * g8[0], od[1] * rs * g8[1]); w.y = pk2(od[2] * rs * g8[2], od[3] * rs * g8[3]); w.z = pk2(od[4] * rs * g8[4], od[5] * rs * g8[5]); w.w = pk2(od[6] * rs * g8[6], od[7] * rs * g8[7]);
        *(GAS v4u*)(YA + (size_t)m * 512 + h * 128 + dch) = w;
    }
}

__device__ __forceinline__ void p2_attention(Frame& F, char* lds) {
    using abf = attn_body::bf16;
    const int v = F.vcu;
    float lam;
    { const int lane = mk_lane(); const float a = F.dlam[lane], b = F.dlam[64 + lane], c = F.dlam[128 + lane], d = F.dlam[192 + lane];
      lam = __uint_as_float(__builtin_amdgcn_readfirstlane(__float_as_uint(expf(wave_sum(a * b)) - expf(wave_sum(c * d)) + 0.2f))); }
    for (int i = 0; i < 4; ++i) {
        const int s = v & 3, qb = (i & 2) ? 7 - s : s, g = i & 1;
        const int b = v >> 4, h = (v >> 2) & 3;
        const abf* Qb = (const abf*)(F.ws + WS_DQ) + ((size_t)b * SEQ + 256 * qb) * 512 + (g * 4 + h) * 64;
        const abf* Kb = (const abf*)(F.ws + WS_DK) + ((size_t)b * KROWS) * 512 + (g * 4 + h) * 64;
        const abf* Vb = (const abf*)(F.ws + WS_DV) + ((size_t)b * KROWS) * 512 + h * 128;
        abf* Ob = (abf*)(F.ws + WS_OD) + ((size_t)b * SEQ + 256 * qb) * 1024 + (g * 4 + h) * 128;
        attn_body::attn_unit_dv2<8, false, false>(F.wave, qb, Qb, Kb, Vb, Ob, 1024, nullptr, lds);
        if (i & 1) {
            asm volatile("s_waitcnt vmcnt(0)" ::: "memory");
            const int lane = mk_lane_v(), r = lane >> 1, hf = lane & 1;
            const size_t row = (size_t)b * SEQ + 256 * qb + 32 * F.wave + r;
            const bf16* o0 = (const bf16*)(F.ws + WS_OD) + row * 1024 + h * 128 + hf * 64;
            const bf16* o1 = o0 + 512;
            v4u a[8], c[8];
#pragma unroll
            for (int q = 0; q < 8; ++q) { a[q] = *(const GAS v4u*)(o0 + 8 * q); c[q] = *(const GAS v4u*)(o1 + 8 * q); }
            float ss = 0.f; float od[64];
#pragma unroll
            for (int q = 0; q < 8; ++q) {
                od[8 * q + 0] = pg8::bf_lo(a[q].x) - lam * pg8::bf_lo(c[q].x); od[8 * q + 1] = pg8::bf_hi(a[q].x) - lam * pg8::bf_hi(c[q].x);
                od[8 * q + 2] = pg8::bf_lo(a[q].y) - lam * pg8::bf_lo(c[q].y); od[8 * q + 3] = pg8::bf_hi(a[q].y) - lam * pg8::bf_hi(c[q].y);
                od[8 * q + 4] = pg8::bf_lo(a[q].z) - lam * pg8::bf_lo(c[q].z); od[8 * q + 5] = pg8::bf_hi(a[q].z) - lam * pg8::bf_hi(c[q].z);
                od[8 * q + 6] = pg8::bf_lo(a[q].w) - lam * pg8::bf_lo(c[q].w); od[8 * q + 7] = pg8::bf_hi(a[q].w) - lam * pg8::bf_hi(c[q].w);
#pragma unroll
                for (int e = 0; e < 8; ++e) ss += od[8 * q + e] * od[8 * q + e];
            }
            ss += dppx<0xB1>(ss);
            const float rs = __builtin_amdgcn_rsqf(ss * (1.0f / 128.0f) + 1e-6f) * 0.8f;
            unsigned char* yo = F.ws + WS_YA + row * 512 + h * 128 + hf * 64;
            const float rsa = rs * SC_A;
#pragma unroll
            for (int q = 0; q < 4; ++q) { const GAS f32x4* gp = (const GAS f32x4*)(F.dsg + hf * 64 + 16 * q); const f32x4 g0 = gp[0], g1 = gp[1], g2 = gp[2], g3 = gp[3];
                v4u w; w.x = pg8::cvt_pk4_fp8(od[16 * q] * rsa * g0.x, od[16 * q + 1] * rsa * g0.y, od[16 * q + 2] * rsa * g0.z, od[16 * q + 3] * rsa * g0.w);
                w.y = pg8::cvt_pk4_fp8(od[16 * q + 4] * rsa * g1.x, od[16 * q + 5] * rsa * g1.y, od[16 * q + 6] * rsa * g1.z, od[16 * q + 7] * rsa * g1.w);
                w.z = pg8::cvt_pk4_fp8(od[16 * q + 8] * rsa * g2.x, od[16 * q + 9] * rsa * g2.y, od[16 * q + 10] * rsa * g2.z, od[16 * q + 11] * rsa * g2.w);
                w.w = pg8::cvt_pk4_fp8(od[16 * q + 12] * rsa * g3.x, od[16 * q + 13] * rsa * g3.y, od[16 * q + 14] * rsa * g3.z, od[16 * q + 15] * rsa * g3.w);
                *(GAS v4u*)(yo + 16 * q) = w; }
        }
    }
    asm volatile("" ::: "memory");
    for (int i = 0; i < 4; ++i) {
        const int fp = 2 * v + (i >> 1), fg = fp >> 2, s = fp & 3, qb = (i & 1) ? 7 - s : s;
        const int b = fg >> 3, h = fg & 7;
        const abf* Qb = (const abf*)(F.ws + WS_FQ) + ((size_t)b * SEQ + 256 * qb) * 512 + h * 64;
        const abf* Kb = (const abf*)(F.ws + WS_FK) + ((size_t)b * KROWS) * 512 + h * 64;
        const abf* Vb = (const abf*)(F.ws + WS_FV) + ((size_t)b * KROWS) * 512 + h * 64;
        abf* Ob = (abf*)(F.ws + WS_OF + ((size_t)b * SEQ + 256 * qb) * 512 + h * 64);
        const float* cbv = (const float*)(F.ws + WS_CB) + (size_t)(b * 8 + h) * KROWS;
        attn_body::attn_unit<8, true>(F.wave, qb, Qb, Kb, Vb, Ob, 512, cbv, lds);
    }
}

typedef float f32x16p __attribute__((ext_vector_type(16)));
typedef __bf16 bf16x2p __attribute__((ext_vector_type(2)));
constexpr int SKROW = 272;
__device__ __forceinline__ unsigned f2key(float f) { const unsigned u = __float_as_uint(f); return u ^ ((unsigned)((int)u >> 31) | 0x80000000u); }
__device__ __forceinline__ float key2f(unsigned k) { const unsigned m = (k & 0x80000000u) ? 0x80000000u : 0xffffffffu; return __uint_as_float(k ^ m); }
#define CEU(a, b) do { const unsigned _h = (a) > (b) ? (a) : (b), _l = (a) > (b) ? (b) : (a); (a) = _h; (b) = _l; } while (0)
__device__ __forceinline__ void sort16_desc(unsigned (&v)[16]) {
#pragma unroll
    for (int k = 2; k <= 16; k <<= 1)
#pragma unroll
        for (int j = k >> 1; j > 0; j >>= 1)
#pragma unroll
            for (int i = 0; i < 16; ++i) { const int l = i ^ j; if (l > i) { if ((i & k) == 0) CEU(v[i], v[l]); else CEU(v[l], v[i]); } }
}
__device__ __forceinline__ void merge16_desc(unsigned (&R)[16], const unsigned (&C)[16]) {
#pragma unroll
    for (int i = 0; i < 16; ++i) R[i] = R[i] > C[15 - i] ? R[i] : C[15 - i];
#pragma unroll
    for (int j = 8; j > 0; j >>= 1)
#pragma unroll
        for (int i = 0; i < 16; ++i) { const int l = i ^ j; if (l > i) CEU(R[i], R[l]); }
}
__device__ __forceinline__ unsigned sel4(unsigned w0, unsigned w1, unsigned w2, unsigned w3, int i) { unsigned r = w0; r = i == 1 ? w1 : r; r = i == 2 ? w2 : r; r = i == 3 ? w3 : r; return r; }

__device__ __forceinline__ void p6_topk(Frame& F) {
    int tid_ = F.wave * 64 + mk_lane(); asm volatile("" : "+v"(tid_));
    const int tid = tid_, lane = tid & 63, wave = F.wave, r32 = lane & 31, hi = lane >> 5;
    const int h = F.vcu & 7, wgh = F.vcu >> 3;
    LAS unsigned char* skl = F.lds;
    { const bf16* SK = (const bf16*)(F.ws + WS_SK) + (size_t)h * 256 * 128;
      for (int idx = tid; idx < 4096; idx += 512) { const int ck = idx >> 4, ch = idx & 15; const v4u val = *(const GAS v4u*)(SK + (size_t)ck * 128 + ch * 8); *(LAS v4u*)(skl + ck * SKROW + ch * 16) = val; } }
    __syncthreads();
    const bf16* Q2 = (const bf16*)(F.ws + WS_Q2);
    bf16x8 qf[2][8];
#define P6_LOADQ(TT) do { const int tk_ = (wgh * 4 + (TT)) * 256 + wave * 32 + r32; _Pragma("unroll") for (int c = 0; c < 2; ++c) _Pragma("unroll") for (int ks = 0; ks < 8; ++ks) \
        qf[c][ks] = *(const GAS bf16x8*)(Q2 + (size_t)tk_ * 2048 + h * 256 + c * 128 + ks * 16 + hi * 8); } while (0)
    P6_LOADQ(0);
    for (int tt = 0; tt < 4; ++tt) {
        const int tok = (wgh * 4 + tt) * 256 + wave * 32 + r32;
        unsigned R[16];
#pragma unroll
        for (int r = 0; r < 16; ++r) R[r] = 0u;
#pragma nounroll
        for (int kt = 0; kt < 4; ++kt) {
            f32x16p a0 = {}, a1 = {};
#pragma unroll
            for (int ks = 0; ks < 8; ++ks) {
                const bf16x8 s0 = *(const LAS bf16x8*)(skl + (0 * 128 + kt * 32 + r32) * SKROW + ks * 32 + hi * 16);
                const bf16x8 s1 = *(const LAS bf16x8*)(skl + (1 * 128 + kt * 32 + r32) * SKROW + ks * 32 + hi * 16);
                a0 = __builtin_amdgcn_mfma_f32_32x32x16_bf16(s0, qf[0][ks], a0, 0, 0, 0);
                a1 = __builtin_amdgcn_mfma_f32_32x32x16_bf16(s1, qf[1][ks], a1, 0, 0, 0);
            }
            unsigned X[16], Y[16];
#pragma unroll
            for (int r = 0; r < 16; ++r) {
                const auto rr = __builtin_amdgcn_permlane32_swap(__float_as_uint(a0[r]), __float_as_uint(a1[r]), false, false);
                const unsigned kidx = (unsigned)(kt * 32 + (r & 3) + 8 * (r >> 2));
                X[r] = (f2key(__uint_as_float(rr[0])) & ~0x7fu) | kidx;
                Y[r] = (f2key(__uint_as_float(rr[1])) & ~0x7fu) | (kidx + 4u);
            }
            sort16_desc(X); sort16_desc(Y);
            merge16_desc(R, X);
            merge16_desc(R, Y);
        }
        if (tt < 3) P6_LOADQ(tt + 1);
        unsigned A[16], B[16];
#pragma unroll
        for (int r = 0; r < 16; ++r) { const auto rr = __builtin_amdgcn_permlane32_swap(R[r], R[r], false, false); A[r] = rr[0]; B[r] = rr[1]; }
        float s1[16], s2[16];
#pragma unroll
        for (int r = 0; r < 16; ++r) { s1[r] = key2f(A[r] & ~0x7fu); s2[r] = key2f(B[r] & ~0x7fu); }
#define PK4(V, q) ((V[4 * q] & 0x7fu) | ((V[4 * q + 1] & 0x7fu) << 8) | ((V[4 * q + 2] & 0x7fu) << 16) | ((V[4 * q + 3] & 0x7fu) << 24))
        const unsigned i1a = PK4(A, 0), i1b = PK4(A, 1), i1c = PK4(A, 2), i1d = PK4(A, 3), i2a = PK4(B, 0), i2b = PK4(B, 1), i2c = PK4(B, 2), i2d = PK4(B, 3);
#undef PK4
#define PKEY(a, b) ((f2key(s1[a] + s2[b]) & ~0xffu) | (unsigned)((a) * 16 + (b)))
        unsigned L[16], C1[16], C2[16], C3[16];
#pragma unroll
        for (int b = 0; b < 16; ++b) L[b] = PKEY(0, b);
#pragma unroll
        for (int b = 0; b < 8; ++b) { C1[b] = PKEY(1, b); C1[8 + b] = PKEY(8 + b, 0); }
#pragma unroll
        for (int b = 0; b < 5; ++b) C2[b] = PKEY(2, b);
#pragma unroll
        for (int b = 0; b < 4; ++b) C2[5 + b] = PKEY(3, b);
#pragma unroll
        for (int b = 0; b < 3; ++b) C2[9 + b] = PKEY(4, b);
        C2[12] = PKEY(5, 0); C2[13] = PKEY(5, 1); C2[14] = PKEY(6, 0); C2[15] = PKEY(6, 1);
        C3[0] = PKEY(7, 0); C3[1] = PKEY(7, 1);
#pragma unroll
        for (int b = 2; b < 16; ++b) C3[b] = 0u;
#undef PKEY
        sort16_desc(C1); sort16_desc(C2);
        merge16_desc(L, C1); merge16_desc(L, C2); merge16_desc(L, C3);
        float val[16]; unsigned eid[16];
#pragma unroll
        for (int k = 0; k < 16; ++k) { const unsigned key = L[k]; const int a = (key >> 4) & 15, b = key & 15; val[k] = key2f(key & ~0xffu);
            const unsigned ia = (sel4(i1a, i1b, i1c, i1d, a >> 2) >> (8 * (a & 3))) & 0x7fu, ib = (sel4(i2a, i2b, i2c, i2d, b >> 2) >> (8 * (b & 3))) & 0x7fu; eid[k] = ia * 128u + ib; }
        float sum = 0.f; const float vmax = val[0];
        float rsl;
        { const GAS f32x4* sp = (const GAS f32x4*)((const float*)(F.ws + WS_SSQP) + (size_t)tok * 16); const f32x4 s0 = sp[0], s1q = sp[1], s2q = sp[2], s3 = sp[3];
          const float tot = ((s0[0] + s0[1]) + (s0[2] + s0[3])) + ((s1q[0] + s1q[1]) + (s1q[2] + s1q[3])) + ((s2q[0] + s2q[1]) + (s2q[2] + s2q[3])) + ((s3[0] + s3[1]) + (s3[2] + s3[3]));
          rsl = __builtin_amdgcn_rsqf(tot * (1.0f / 1024.0f) + 1e-6f) * LOG2E; }
#pragma unroll
        for (int k = 0; k < 16; ++k) { val[k] = __builtin_amdgcn_exp2f((val[k] - vmax) * rsl); sum += val[k]; }
        const float inv = 1.0f / sum;
        if (hi == 0) {
            GAS v4u* ep = (GAS v4u*)((unsigned short*)(F.ws + WS_EIDX) + (size_t)tok * 128 + h * 16);
            ep[0] = (v4u){eid[0] | (eid[1] << 16), eid[2] | (eid[3] << 16), eid[4] | (eid[5] << 16), eid[6] | (eid[7] << 16)};
            ep[1] = (v4u){eid[8] | (eid[9] << 16), eid[10] | (eid[11] << 16), eid[12] | (eid[13] << 16), eid[14] | (eid[15] << 16)};
            GAS f32x4* gp = (GAS f32x4*)((float*)(F.ws + WS_GATE) + (size_t)tok * 128 + h * 16);
#pragma unroll
            for (int q = 0; q < 4; ++q) gp[q] = (f32x4){val[4 * q] * inv, val[4 * q + 1] * inv, val[4 * q + 2] * inv, val[4 * q + 3] * inv};
        }
    }
#undef P6_LOADQ
    __syncthreads();
}

__device__ __forceinline__ float gelu_erf(float v) {
    const float av = fabsf(v), t = __builtin_amdgcn_rcpf(1.0f + 0.2316418882f * av);
    float q = t * 0.5307027145f + (-0.7265760135f); q = q * t + 0.7107068705f; q = q * t + (-0.142248368f); q = q * t + 0.127414796f; q = q * t;
    const float e = __builtin_amdgcn_exp2f((v * v) * (-0.72134752044f));
    const float m = v * (q * e);
    return v < 0.f ? m : v - m;
}
__device__ __forceinline__ float dot2bf(unsigned a, unsigned b, float acc) { return __builtin_amdgcn_fdot2_f32_bf16(__builtin_bit_cast(bf16x2p, a), __builtin_bit_cast(bf16x2p, b), acc, false); }
__device__ __forceinline__ float dot8(const v4u a, const v4u b, float acc) {
    const unsigned a0 = a.x, a1 = a.y, a2 = a.z, a3 = a.w, b0 = b.x, b1 = b.y, b2 = b.z, b3 = b.w;
    acc = dot2bf(a0, b0, acc); acc = dot2bf(a1, b1, acc); acc = dot2bf(a2, b2, acc); acc = dot2bf(a3, b3, acc);
    return acc;
}
typedef float f32x2p __attribute__((ext_vector_type(2)));
constexpr float U_SCALE = 256.0f, V_SCALE = 32.0f;
__device__ __forceinline__ void fp8x16_to_f32(const v4u r, float (&f)[16]) {
    const unsigned w0 = r.x, w1 = r.y, w2 = r.z, w3 = r.w;
    f32x2p a;
    a = __builtin_amdgcn_cvt_pk_f32_fp8((int)w0, false); f[0] = a.x; f[1] = a.y; a = __builtin_amdgcn_cvt_pk_f32_fp8((int)w0, true); f[2] = a.x; f[3] = a.y;
    a = __builtin_amdgcn_cvt_pk_f32_fp8((int)w1, false); f[4] = a.x; f[5] = a.y; a = __builtin_amdgcn_cvt_pk_f32_fp8((int)w1, true); f[6] = a.x; f[7] = a.y;
    a = __builtin_amdgcn_cvt_pk_f32_fp8((int)w2, false); f[8] = a.x; f[9] = a.y; a = __builtin_amdgcn_cvt_pk_f32_fp8((int)w2, true); f[10] = a.x; f[11] = a.y;
    a = __builtin_amdgcn_cvt_pk_f32_fp8((int)w3, false); f[12] = a.x; f[13] = a.y; a = __builtin_amdgcn_cvt_pk_f32_fp8((int)w3, true); f[14] = a.x; f[15] = a.y;
}
template <int CTRL> __device__ __forceinline__ float dppf(float x) { return __builtin_amdgcn_update_dpp(0.f, x, CTRL, 0xf, 0xf, true); }
__device__ __forceinline__ float oct_sum(float v) { v += dppf<0xB1>(v); v += dppf<0x4E>(v); v += dppf<0x141>(v); return v; }

struct UIn { v4u id0, id1, x0, x1; };
__device__ __forceinline__ UIn p7a_in(const unsigned char* EIb, const unsigned char* Hb, unsigned t, unsigned oct, unsigned xoff) {
    UIn r; const unsigned eo = t * 256u + 32u * oct, xo = t * 2048u + xoff;
    r.id0 = *(const GAS v4u*)(EIb + eo); r.id1 = *(const GAS v4u*)(EIb + (eo + 16u));
    r.x0 = *(const GAS v4u*)(Hb + xo); r.x1 = *(const GAS v4u*)(Hb + (xo + 16u)); return r;
}
__device__ __forceinline__ void p7_rows8(const unsigned char* TB, unsigned lo, const v4u id, v4u (&rows)[8]) {
    const unsigned ix = id.x, iy = id.y, iz = id.z, iw = id.w;
    rows[0] = *(const GAS v4u*)(TB + ((ix & 0xffffu) * 128u + lo)); rows[1] = *(const GAS v4u*)(TB + ((ix >> 16) * 128u + lo));
    rows[2] = *(const GAS v4u*)(TB + ((iy & 0xffffu) * 128u + lo)); rows[3] = *(const GAS v4u*)(TB + ((iy >> 16) * 128u + lo));
    rows[4] = *(const GAS v4u*)(TB + ((iz & 0xffffu) * 128u + lo)); rows[5] = *(const GAS v4u*)(TB + ((iz >> 16) * 128u + lo));
    rows[6] = *(const GAS v4u*)(TB + ((iw & 0xffffu) * 128u + lo)); rows[7] = *(const GAS v4u*)(TB + ((iw >> 16) * 128u + lo));
}
typedef _Float16 h2p __attribute__((ext_vector_type(2)));
#define CVH(w, s, sel) __builtin_bit_cast(h2p, __builtin_amdgcn_cvt_scalef32_pk_f16_fp8(w, s, sel))
__device__ __forceinline__ h2p bf2_to_h2(unsigned w) { const f32x2p f = {pg8::bf_lo(w), pg8::bf_hi(w)}; return __builtin_convertvector(f, h2p); }
constexpr float U8_SCALE = 508.0f;
template <int CTRL> __device__ __forceinline__ int dppi(int x) { return __builtin_amdgcn_update_dpp(0, x, CTRL, 0xf, 0xf, true); }
__device__ __forceinline__ int oct_sum_i(int v) { v += dppi<0xB1>(v); v += dppi<0x4E>(v); v += dppi<0x141>(v); return v; }
__device__ __forceinline__ float oct_max(float v) { v = fmaxf(v, dppf<0xB1>(v)); v = fmaxf(v, dppf<0x4E>(v)); v = fmaxf(v, dppf<0x141>(v)); return v; }
__device__ __forceinline__ unsigned pack4_i8(float a, float b, float c, float d, float qs) {
    const int q0 = (int)__builtin_rintf(a * qs), q1 = (int)__builtin_rintf(b * qs), q2 = (int)__builtin_rintf(c * qs), q3 = (int)__builtin_rintf(d * qs);
    return (unsigned)(q0 & 255) | ((unsigned)(q1 & 255) << 8) | ((unsigned)(q2 & 255) << 16) | ((unsigned)q3 << 24);
}
__device__ __forceinline__ void p7a_half(const v4u (&rows)[8], const unsigned (&xq)[4], float dq, float (&p)[8]) {
#pragma unroll
    for (int j = 0; j < 8; ++j) { const unsigned w0 = rows[j].x, w1 = rows[j].y, w2 = rows[j].z, w3 = rows[j].w;
        int a = __builtin_amdgcn_sdot4((int)w0, (int)xq[0], 0, false); a = __builtin_amdgcn_sdot4((int)w1, (int)xq[1], a, false);
        a = __builtin_amdgcn_sdot4((int)w2, (int)xq[2], a, false); a = __builtin_amdgcn_sdot4((int)w3, (int)xq[3], a, false);
        p[j] = (float)oct_sum_i(a) * dq;
        if (j & 1) __builtin_amdgcn_sched_barrier(0); }
}
__device__ __forceinline__ void p7a_udot(Frame& F) {
    int lane_ = mk_lane(); asm volatile("" : "+v"(lane_));
    const int lane = lane_, wave = F.wave, oct = lane >> 3, li8 = lane & 7;
    const int nloc = (int)F.MISC[8], nx = (int)F.MISC[9], rank = (int)F.MISC[10], xidx = (int)F.MISC[11];
    for (int sl = xidx; sl < 8; sl += nx) {
    const unsigned char* US = F.ws + WS_US8 + (size_t)sl * 16384 * 128; const unsigned lo = (unsigned)li8 * 16u;
    _Float16* PD = (_Float16*)(F.ws + WS_PD) + (size_t)sl * MROWS * 128;
    const unsigned char* H1B = F.ws + WS_H1B;
    const unsigned short* EI = (const unsigned short*)(F.ws + WS_EIDX);
    int tb_ = __builtin_amdgcn_readfirstlane(rank * 8 + wave); asm volatile("" : "+s"(tb_));
    const int tb = tb_, tstep = nloc * 8, nit = (MROWS - tb + tstep - 1) / tstep;
#define TOK(i) min(tb + tstep * (i), MROWS - 1)
    const unsigned char* EIb = (const unsigned char*)EI; const unsigned char* Hb = (const unsigned char*)H1B; const unsigned xoff = (unsigned)(128 * sl + 16 * li8) * 2u;
    UIn cur = p7a_in(EIb, Hb, (unsigned)TOK(0), (unsigned)oct, xoff);
    v4u rowsA[8], rowsB[8];
    p7_rows8(US, lo, cur.id0, rowsA);
    for (int i = 0; i < nit; ++i) {
        p7_rows8(US, lo, cur.id1, rowsB);
        const UIn nxt = p7a_in(EIb, Hb, (unsigned)TOK(i + 1), (unsigned)oct, xoff);
        const unsigned xw[8] = {cur.x0.x, cur.x0.y, cur.x0.z, cur.x0.w, cur.x1.x, cur.x1.y, cur.x1.z, cur.x1.w};
        float xf[16]; float am = 0.f;
#pragma unroll
        for (int q = 0; q < 8; ++q) { xf[2 * q] = pg8::bf_lo(xw[q]); xf[2 * q + 1] = pg8::bf_hi(xw[q]); am = fmaxf(am, fmaxf(fabsf(xf[2 * q]), fabsf(xf[2 * q + 1]))); }
        am = fmaxf(oct_max(am), 1e-20f);
        const float qs = 127.0f * __builtin_amdgcn_rcpf(am), dq = am * (1.0f / (127.0f * U8_SCALE));
        const unsigned xs[4] = {pack4_i8(xf[0], xf[1], xf[2], xf[3], qs), pack4_i8(xf[4], xf[5], xf[6], xf[7], qs), pack4_i8(xf[8], xf[9], xf[10], xf[11], qs), pack4_i8(xf[12], xf[13], xf[14], xf[15], qs)};
        float pa[8], pb[8];
        __builtin_amdgcn_sched_barrier(0);
        p7a_half(rowsA, xs, dq, pa);
        __builtin_amdgcn_sched_barrier(0);
        p7_rows8(US, lo, nxt.id0, rowsA);
        __builtin_amdgcn_sched_barrier(0);
        p7a_half(rowsB, xs, dq, pb);
        __builtin_amdgcn_sched_barrier(0);
        if (li8 < 4) {
            f32x4 o;
            o.x = li8 == 0 ? pa[0] : li8 == 1 ? pa[4] : li8 == 2 ? pb[0] : pb[4];
            o.y = li8 == 0 ? pa[1] : li8 == 1 ? pa[5] : li8 == 2 ? pb[1] : pb[5];
            o.z = li8 == 0 ? pa[2] : li8 == 1 ? pa[6] : li8 == 2 ? pb[2] : pb[6];
            o.w = li8 == 0 ? pa[3] : li8 == 1 ? pa[7] : li8 == 2 ? pb[3] : pb[7];
            const f32x2p lo2 = {o.x, o.y}, hi2 = {o.z, o.w};
            v2u w; w.x = __builtin_bit_cast(unsigned, __builtin_convertvector(lo2, h2p)); w.y = __builtin_bit_cast(unsigned, __builtin_convertvector(hi2, h2p));
            *(GAS v2u*)(PD + (size_t)TOK(i) * 128 + 16 * oct + 4 * li8) = w;
        }
        cur = nxt;
    }
    }
}
__device__ __forceinline__ void p7b_weights(Frame& F) {
    int lane_ = mk_lane(); asm volatile("" : "+v"(lane_));
    const int lane = lane_, gw = F.vcu * NWAVES + F.wave, NGW = F.G * NWAVES;
    const _Float16* PD = (const _Float16*)(F.ws + WS_PD); const float* GT = (const float*)(F.ws + WS_GATE); _Float16* W = (_Float16*)(F.ws + WS_W);
    for (int t0 = gw; t0 < MROWS; t0 += 4 * NGW) {
        unsigned pd[4][8]; f32x2p gt[4]; float sq[4];
#pragma unroll
        for (int j = 0; j < 4; ++j) { const int t = min(t0 + j * NGW, MROWS - 1);
            sq[j] = lane < 16 ? ((const GAS float*)(F.ws + WS_SSQP))[(size_t)t * 16 + lane] : 0.f;
#pragma unroll
            for (int x = 0; x < 8; ++x) pd[j][x] = *(const GAS unsigned*)(PD + ((size_t)x * MROWS + t) * 128 + 2 * lane);
            gt[j] = *(const GAS f32x2p*)(GT + (size_t)t * 128 + 2 * lane); }
#pragma unroll
        for (int j = 0; j < 4; ++j) { const int t = t0 + j * NGW;
            const float rs = __builtin_amdgcn_rsqf(wave_sum(sq[j]) * (1.0f / 1024.0f) + 1e-6f);
            float d0 = 0.f, d1 = 0.f;
#pragma unroll
            for (int x = 0; x < 8; ++x) { const unsigned w_ = pd[j][x]; const h2p hv = __builtin_bit_cast(h2p, w_); d0 += (float)hv.x; d1 += (float)hv.y; }
            const f32x2p wv = {gt[j].x * gelu_erf(d0 * rs), gt[j].y * gelu_erf(d1 * rs)};
            if (t < MROWS) *(GAS unsigned*)(W + (size_t)t * 128 + 2 * lane) = __builtin_bit_cast(unsigned, __builtin_convertvector(wv, h2p)); }
    }
}
struct VIn { v4u id0, id1, wa, wb; v2u h; };
__device__ __forceinline__ VIn p7c_in(const unsigned char* EIb, const unsigned char* Wb, const unsigned char* hb, unsigned t, unsigned g, unsigned ooff) {
    VIn r; const unsigned eo = t * 256u + 32u * g;
    r.id0 = *(const GAS v4u*)(EIb + eo); r.id1 = *(const GAS v4u*)(EIb + (eo + 16u));
    r.wa = *(const GAS v4u*)(Wb + eo); r.wb = *(const GAS v4u*)(Wb + (eo + 16u));
    r.h = *(const GAS v2u*)(hb + (t * 2048u + (ooff >> 1))); return r;
}
__device__ __forceinline__ float h_lo(unsigned w) { return (float)__builtin_bit_cast(h2p, w).x; }
__device__ __forceinline__ float h_hi(unsigned w) { return (float)__builtin_bit_cast(h2p, w).y; }
#define CVH(w, s, sel) __builtin_bit_cast(h2p, __builtin_amdgcn_cvt_scalef32_pk_f16_fp8(w, s, sel))
__device__ __forceinline__ void p7c_half(const v4u (&rows)[8], const v4u wq, h2p (&acc)[8]) {
    const unsigned q0 = wq.x, q1 = wq.y, q2 = wq.z, q3 = wq.w;
    const h2p w01 = __builtin_bit_cast(h2p, q0), w23 = __builtin_bit_cast(h2p, q1), w45 = __builtin_bit_cast(h2p, q2), w67 = __builtin_bit_cast(h2p, q3);
    const h2p wv[8] = {{w01.x, w01.x}, {w01.y, w01.y}, {w23.x, w23.x}, {w23.y, w23.y}, {w45.x, w45.x}, {w45.y, w45.y}, {w67.x, w67.x}, {w67.y, w67.y}};
#pragma unroll
    for (int j = 0; j < 8; ++j) {
        unsigned r0 = rows[j].x, r1 = rows[j].y, r2 = rows[j].z, r3 = rows[j].w;
        asm volatile("" : "+v"(r0), "+v"(r1), "+v"(r2), "+v"(r3), "+v"(acc[0]));
        const float isc = 1.0f;
        acc[0] = __builtin_elementwise_fma(CVH(r0, isc, false), wv[j], acc[0]); acc[1] = __builtin_elementwise_fma(CVH(r0, isc, true), wv[j], acc[1]);
        acc[2] = __builtin_elementwise_fma(CVH(r1, isc, false), wv[j], acc[2]); acc[3] = __builtin_elementwise_fma(CVH(r1, isc, true), wv[j], acc[3]);
        acc[4] = __builtin_elementwise_fma(CVH(r2, isc, false), wv[j], acc[4]); acc[5] = __builtin_elementwise_fma(CVH(r2, isc, true), wv[j], acc[5]);
        acc[6] = __builtin_elementwise_fma(CVH(r3, isc, false), wv[j], acc[6]); acc[7] = __builtin_elementwise_fma(CVH(r3, isc, true), wv[j], acc[7]);
    }
}
__device__ __forceinline__ void p7c_vsum(Frame& F) {
    int lane_ = mk_lane(); asm volatile("" : "+v"(lane_));
    const int lane = lane_, wave = F.wave, oct = lane >> 3, li8 = lane & 7;
    const int nloc = (int)F.MISC[8], nx = (int)F.MISC[9], rank = (int)F.MISC[10], xidx = (int)F.MISC[11];
    LAS float* red = (LAS float*)F.lds + wave * 1024;
    const float* W = (const float*)(F.ws + WS_W);
    const unsigned short* EI = (const unsigned short*)(F.ws + WS_EIDX);
    for (int sl = xidx; sl < 8; sl += nx) {
    const unsigned char* VS = F.ws + WS_VS8 + (size_t)sl * 16384 * 128; const unsigned lo = (unsigned)li8 * 16u;
    int tb_ = __builtin_amdgcn_readfirstlane(rank * 8 + wave); asm volatile("" : "+s"(tb_));
    const int tb = tb_, tstep = nloc * 8, nit = (MROWS - tb + tstep - 1) / tstep;
    const unsigned char* EIb = (const unsigned char*)EI; const unsigned char* Wb = (const unsigned char*)W; unsigned char* ob = (unsigned char*)F.out;
    const unsigned ooff = (unsigned)(128 * sl + 4 * (lane & 31)) * 4u;
    const unsigned char* hb = F.ws + WS_H1B;
    VIn cur = p7c_in(EIb, Wb, hb, (unsigned)TOK(0), (unsigned)oct, ooff);
    v4u rowsA[8], rowsB[8];
    p7_rows8(VS, lo, cur.id0, rowsA);
    for (int i = 0; i < nit; ++i) {
        p7_rows8(VS, lo, cur.id1, rowsB);
        const VIn nxt = p7c_in(EIb, Wb, hb, (unsigned)TOK(i + 1), (unsigned)oct, ooff);
        h2p acch[8];
#pragma unroll
        for (int q = 0; q < 8; ++q) acch[q] = (h2p){(_Float16)0.f, (_Float16)0.f};
        __builtin_amdgcn_sched_barrier(0);
        p7c_half(rowsA, cur.wa, acch);
        __builtin_amdgcn_sched_barrier(0);
        p7_rows8(VS, lo, nxt.id0, rowsA);
        __builtin_amdgcn_sched_barrier(0);
        p7c_half(rowsB, cur.wb, acch);
        __builtin_amdgcn_sched_barrier(0);
        float acc[16];
#pragma unroll
        for (int q = 0; q < 8; ++q) { acc[2 * q] = (float)acch[q].x; acc[2 * q + 1] = (float)acch[q].y; }
        LAS f32x4* rw = (LAS f32x4*)(red + lane * 16);
        rw[0] = (f32x4){acc[0], acc[1], acc[2], acc[3]}; rw[1] = (f32x4){acc[4], acc[5], acc[6], acc[7]}; rw[2] = (f32x4){acc[8], acc[9], acc[10], acc[11]}; rw[3] = (f32x4){acc[12], acc[13], acc[14], acc[15]};
        LDS_WAIT();
        if (lane < 32) {
            const LAS f32x4* rr = (const LAS f32x4*)(red + (lane >> 2) * 16 + (lane & 3) * 4);
            f32x4 s = rr[0];
#pragma unroll
            for (int o = 1; o < 8; ++o) s += rr[o * 32];
            const f32x4 hres = {pg8::bf_lo(cur.h.x), pg8::bf_hi(cur.h.x), pg8::bf_lo(cur.h.y), pg8::bf_hi(cur.h.y)};
            *(GAS f32x4*)(ob + ((unsigned)TOK(i) * 4096u + ooff)) = hres + s * (1.0f / V_SCALE);
        }
        LDS_WAIT();
        cur = nxt;
    }
    }
}
#undef TOK


struct Args { const float* in[20]; float* out; unsigned char* ws; int ph_lo, ph_hi, li, dup; };
__global__ void __launch_bounds__(NWAVES * 64, 2) mk_fwd(Args args) {
    extern __shared__ __attribute__((aligned(16))) unsigned char lds[];
    Frame F;
    F.lds = (LAS unsigned char*)lds;
    F.MISC = (volatile LAS unsigned*)(F.lds + MISC_OFF);
    F.tid = threadIdx.x; F.lane = F.tid & 63; F.wave = __builtin_amdgcn_readfirstlane(F.tid >> 6);
    F.G = gridDim.x; { const int bx = blockIdx.x; F.vcu = (F.G % 8 == 0) ? (bx % 8) * (F.G / 8) + bx / 8 : bx; }
    unsigned char* ws = args.ws; F.ws = ws;
    F.ctl = (gu32*)(ws + WS_CTL);
    F.x = args.in[0]; F.meta = args.in[1]; F.gmix = args.in[2]; F.win = args.in[3]; F.bgate = args.in[4]; F.bforget = args.in[5]; F.dqg = args.in[6]; F.dkg = args.in[7]; F.dlam = args.in[8]; F.dsg = args.in[9];
    F.fqg = args.in[10]; F.fkg = args.in[11]; F.wbd = args.in[12]; F.wbf = args.in[13]; F.wout = args.in[14]; F.gffn = args.in[15]; F.wq = args.in[16]; F.sk = args.in[17]; F.u = args.in[18]; F.v = args.in[19];
    F.out = args.out;
    for (int u = F.tid; u < (LDS_BYTES - LDSCTL_OFF) / 4; u += NWAVES * 64) ((LAS unsigned*)(F.lds + LDSCTL_OFF))[u] = 0u;
    __syncthreads();
    XcdBarrier bar = xcd_barrier_post((unsigned*)(F.ctl + CW_BAR) + args.li * XCD_BAR_WORDS, F.MISC + 8); bar.wv = F.wave;
    const int lo = args.ph_lo, hi = args.ph_hi;
#define IN(k) (lo <= (k) && (k) < hi)
#define BOTH(k) (IN(k) && IN((k) + 1))
#define GRID_BAR() xcd_barrier(bar)
#define REP(k, ...) do { __VA_ARGS__; if constexpr (((DUPMASK) >> (k)) & 1) { asm volatile("" ::: "memory"); __VA_ARGS__; } } while (0)

    if (IN(0)) { REP(0, p0_prologue(F)); if (BOTH(0)) GRID_BAR(); }

    if (IN(1)) {
        if (F.vcu < 128) p1_cumscan(F, F.vcu);
        pg8::Gemm g{(const bf16*)(ws + WS_XB), (const bf16*)(ws + WS_WIN), MROWS, 5120, 512}; pg8::StaticOrder S; S.init(MROWS, 5120, F.G, (int)blockIdx.x);
        LAS float* etab = (LAS float*)(F.lds + EPI_TAB_OFF);
        for (int i = F.wave * 64 + mk_lane(); i < 2304; i += NWAVES * 64) etab[i] = i < 256 ? ((const float*)(ws + WS_GAINS))[i] : F.bgate[i - 256];
        __syncthreads();
        pg8::EpiProj E{ws, etab, etab + 256, 1.0f / (SC_X * SC_W)};
        REP(1, pg8::gemm_phase<pg8::EpiProj, pg8::StaticOrder, true, true, true>(F.wave, F.lds + RING_OFF, g, S, E));
        if (BOTH(1)) GRID_BAR();
    }
    if (IN(2)) { REP(2, p2_attention(F, (char*)lds + RING_OFF)); if (BOTH(2)) GRID_BAR(); }
    if (IN(4)) {
        int k3 = 256; asm volatile("" : "+s"(k3));
        pg8::Gemm g{(const bf16*)(ws + WS_YA), (const bf16*)(ws + WS_WBD), MROWS, 1024, k3}; pg8::StaticOrder S; S.init(MROWS, 1024, F.G, (int)blockIdx.x);
        pg8::EpiGateT<false> E{ws};
        REP(4, pg8::gemm_phase<pg8::EpiGateT<false>, pg8::StaticOrder, true, true, true>(F.wave, F.lds + RING_OFF, g, S, E));
    }
    if (IN(5)) {
        int k3 = 256; asm volatile("" : "+s"(k3));
        pg8::Gemm g{(const bf16*)(ws + WS_OF), (const bf16*)(ws + WS_WBF), MROWS, 1024, k3}; pg8::StaticOrder S; S.init(MROWS, 1024, F.G, (int)blockIdx.x);
        pg8::EpiGateT<true> E{ws};
        REP(5, pg8::gemm_phase<pg8::EpiGateT<true>, pg8::StaticOrder, true, true, true>(F.wave, F.lds + RING_OFF, g, S, E));
        if (BOTH(5)) GRID_BAR();
    }
    if (IN(6)) {
        pg8::Gemm g{(const bf16*)(ws + WS_MERGED), (const bf16*)(ws + WS_WOUT), MROWS, 1024, 512}; pg8::StaticOrder S; S.init(MROWS, 1024, F.G, (int)blockIdx.x);
#ifdef HYB_H1F
        pg8::EpiMix E{F.x, (float*)(ws + WS_GA), (bf16*)(ws + WS_H1B), (float*)(ws + WS_SSQP), 1.0f / (SC_M * SC_W)};
#else
        pg8::EpiMix E{F.x, nullptr, (bf16*)(ws + WS_H1B), (float*)(ws + WS_SSQP), 1.0f / (SC_M * SC_W)};
#endif
        REP(6, pg8::gemm_phase<pg8::EpiMix, pg8::StaticOrder, true, true, true>(F.wave, F.lds + RING_OFF, g, S, E));
        if (BOTH(6)) GRID_BAR();
    }
    if (IN(7)) {
        pg8::Gemm g{(const bf16*)(ws + WS_H1B), (const bf16*)(ws + WS_WQ), MROWS, 2048, 1024}; pg8::StaticOrder S; S.init(MROWS, 2048, F.G, (int)blockIdx.x);
        pg8::EpiQ2 E{(bf16*)(ws + WS_Q2), 1.0f};
        REP(7, pg8::gemm_phase<pg8::EpiQ2, pg8::StaticOrder, true, true, false>(F.wave, F.lds + RING_OFF, g, S, E));
        if (BOTH(7)) GRID_BAR();
    }
        if (IN(8)) { REP(8, p6_topk(F)); if (BOTH(8)) GRID_BAR(); }
    if (IN(9)) { REP(9, p7a_udot(F)); if (BOTH(9)) GRID_BAR(); }
    if (IN(10)) { REP(10, p7b_weights(F)); if (BOTH(10)) GRID_BAR(); }
    if (IN(11)) { p7c_vsum(F); }

#undef IN
#undef BOTH
}
static int g_grid = 0;
static void mk_setup() {
    if (g_grid) return;
    int dev = 0, cus = 0;
    (void)hipGetDevice(&dev); (void)hipDeviceGetAttribute(&cus, hipDeviceAttributeMultiprocessorCount, dev);
    (void)hipFuncSetAttribute((const void*)mk_fwd, hipFuncAttributeMaxDynamicSharedMemorySize, LDS_BYTES);
    int per_cu = 0; (void)hipOccupancyMaxActiveBlocksPerMultiprocessor(&per_cu, (const void*)mk_fwd, NWAVES * 64, LDS_BYTES); (void)hipGetLastError();
    if (per_cu < 1) fprintf(stderr, "mk_fwd: occupancy query says %d blocks/CU\n", per_cu);
    if (cus != 256) fprintf(stderr, "mk_fwd: built for a 256-CU MI355X (found %d CUs); the work partition assumes 256 resident workgroups\n", cus);
    g_grid = 256;
}
extern "C" void kernel_launch(void* const* d_in, const int* in_sizes, int n_in, void* d_out, int out_size, void* d_ws, size_t ws_size, hipStream_t stream) {
    mk_setup();
    (void)hipMemsetAsync((char*)d_ws + WS_CTL, 0, CTL_ZERO_BYTES, stream);
    Args a{};
    for (int i = 0; i < 20; ++i) a.in[i] = (const float*)d_in[i];
    a.out = (float*)d_out; a.ws = (unsigned char*)d_ws; a.ph_lo = 0; a.ph_hi = N_PHASES; a.li = 0; a.dup = DUPMASK;
    hipLaunchKernelGGL(mk_fwd, dim3(g_grid), dim3(NWAVES * 64), LDS_BYTES, stream, a);
}
```

```cpp
#include <hip/hip_runtime.h>
#include <hip/hip_bf16.h>
#include <cstdio>
#include <cstdint>
#include <cmath>
#ifndef DUPMASK
#define DUPMASK 0
#endif
constexpr size_t MiB = 1u << 20;
constexpr size_t WS_CTL = 0, CTL_ZERO_BYTES = 1 * MiB;
constexpr size_t WS_LOGFM = 1 * MiB;
constexpr size_t WS_GAINS = 1 * MiB + 4096;
constexpr size_t WS_WIN = 2 * MiB, WS_WBD = 12 * MiB, WS_WBF = 13 * MiB, WS_WOUT = 14 * MiB, WS_WQ = 16 * MiB, WS_SK = 20 * MiB;
constexpr size_t WS_CB = 21 * MiB;
constexpr size_t WS_LOGF = 23 * MiB;
constexpr size_t WS_US8 = 24 * MiB, WS_VS8 = 40 * MiB, WS_W = 56 * MiB;
constexpr size_t WS_XB = 88 * MiB;
constexpr size_t WS_DQ = 152 * MiB, WS_DK = 184 * MiB, WS_DV = 217 * MiB, WS_FQ = 250 * MiB, WS_FK = 282 * MiB, WS_FV = 315 * MiB;
constexpr size_t WS_GA = 348 * MiB, WS_GB = 412 * MiB, WS_OF = 476 * MiB, WS_SSQP = 508 * MiB, WS_END = 510 * MiB;
constexpr size_t WS_OD = WS_XB, WS_YA = 56 * MiB  , WS_TMP = WS_FQ, WS_MERGED = WS_DK, WS_H1B = WS_XB, WS_Q2 = WS_GA, WS_EIDX = 250 * MiB, WS_GATE = 258 * MiB, WS_PD = WS_GA;
constexpr int CW_TMO = 0;
constexpr int CW_BAR = 4096;

__device__ __forceinline__ int mk_lane() { return (int)__builtin_amdgcn_mbcnt_hi(~0u, __builtin_amdgcn_mbcnt_lo(~0u, 0u)); }
__device__ __forceinline__ int mk_lane_v() { int l; asm volatile("v_mbcnt_lo_u32_b32 %0, -1, 0\n\tv_mbcnt_hi_u32_b32 %0, -1, %0" : "=v"(l)); return l; }
namespace pg8 {
#define PG8_LAS __attribute__((address_space(3)))
typedef unsigned short bf16_t;
typedef short bf16x8 __attribute__((ext_vector_type(8)));
typedef float f32x4 __attribute__((ext_vector_type(4)));
typedef unsigned u32x4 __attribute__((ext_vector_type(4)));
constexpr int BM = 256, BK = 64, HALF = 128, HTB = HALF * BK * 2  , STAGE_BYTES = 8 * HTB, NXCD = 8, WGM = 8;

__host__ __device__ __forceinline__ int lds_byte(int r, int c) { const int st = (r >> 4) * 2 + (c >> 5), rr = r & 15, cc = c & 31, ob = rr * 64 + cc * 2; return st * 1024 + (ob ^ (((ob >> 9) & 1) << 5)); }
__host__ __device__ __forceinline__ void stage_rc(int b, int& R, int& C) { const int st = b / 1024, sb = b % 1024, swz = sb ^ (((sb >> 9) & 1) << 5); R = (st >> 1) * 16 + swz / 64; C = (st & 1) * 32 + (swz % 64) / 2; }
__host__ __device__ __forceinline__ int perm32(int rho) { const int n = rho >> 4, i = rho & 15; return 8 * (i >> 2) + 4 * n + (i & 3); }

struct Unit { int pm, pn, sel; };
struct Gemm { const bf16_t* A; const bf16_t* Bt; int M, N, K; const bf16_t* A2; const bf16_t* Bt2; };

struct StaticOrder {
    int nM, nN, nwg, G, c;
    __host__ __device__ void init(int M, int N, int G_, int c_) { nM = M / BM; nN = N / BM; nwg = nM * nN; G = G_; c = c_; }
    __host__ __device__ bool next(int i, Unit& u) const {
        const long L = (long)i * G + c; if (L >= nwg) return false;
        int wgid = (int)L; { const int q = nwg / NXCD, r = nwg % NXCD, xcd = wgid % NXCD, off = wgid / NXCD; wgid = (xcd < r ? xcd * (q + 1) : r * (q + 1) + (xcd - r) * q) + off; }
        const int nig = WGM * nN, gid = wgid / nig, fm = gid * WGM, gsz = (nM - fm) < WGM ? (nM - fm) : WGM;
        u.pm = fm + ((wgid % nig) % gsz); u.pn = (wgid % nig) / gsz; u.sel = 0; return true;
    }
    __device__ __forceinline__ void a_ready(const Unit&) const {}
    __device__ __forceinline__ void done(const Unit&) const {}
};
struct PairOrder {
    StaticOrder b;
    __host__ __device__ bool next(int i, Unit& u) const { const bool ok = b.next(i >> 1, u); u.sel = i & 1; return ok; }
    __device__ __forceinline__ void a_ready(const Unit&) const {}
    __device__ __forceinline__ void done(const Unit&) const {}
};

typedef float f32x2_cv __attribute__((ext_vector_type(2))); typedef __bf16 bf16x2_cv __attribute__((ext_vector_type(2)));
__device__ __forceinline__ unsigned cvt_pk_bf16(float lo, float hi) { f32x2_cv v = {lo, hi}; bf16x2_cv b = __builtin_convertvector(v, bf16x2_cv); return __builtin_bit_cast(unsigned, b); }
__device__ __forceinline__ float bf_lo(unsigned w) { return __uint_as_float(w << 16); }
__device__ __forceinline__ float bf_hi(unsigned w) { return __uint_as_float(w & 0xffff0000u); }
__device__ __forceinline__ unsigned cvt_pk4_fp8(float a, float b, float c, float d) { int p = __builtin_amdgcn_cvt_pk_fp8_f32(a, b, 0, false); p = __builtin_amdgcn_cvt_pk_fp8_f32(c, d, p, true); return (unsigned)p; }
typedef unsigned u32x2 __attribute__((ext_vector_type(2)));
constexpr float C2F = 0.125f * 1.4426950408889634f;
constexpr int KROWS = 2112;

struct EpiProj {
    static constexpr bool PERM = true, AFTER_DRAIN = false, PRIO3 = true;
    unsigned char* ws;
    const PG8_LAS float* gains;
    const PG8_LAS float* bgate;
    float dsc;
    __device__ __forceinline__ void operator()(const f32x4 (&acc)[2][2][4][2], const Unit& u, int wr, int wc, int fr_in, int fq_in) const {
        int fr = fr_in, fq = fq_in; asm volatile("" : "+v"(fr), "+v"(fq));
        const int pn = u.pn;
        const int rowt = u.pm * BM + wr * 64 + fr;
        if (pn < 4 || (pn >= 6 && pn < 10)) {
            const bool isdiff = pn < 4;
            const bool isq = isdiff ? (pn < 2) : (pn < 8);
            const PG8_LAS float* gain = gains + (isdiff ? (isq ? 0 : 64) : (isq ? 128 : 192));
            bf16_t* outp = (bf16_t*)(ws + (isdiff ? (isq ? WS_DQ : WS_DK) : (isq ? WS_FQ : WS_FK)));
            const float osc = isq ? C2F : 1.0f;
            f32x4 gv[2][2];
#pragma unroll
            for (int bj = 0; bj < 2; ++bj)
#pragma unroll
                for (int n = 0; n < 2; ++n) gv[bj][n] = *(const PG8_LAS f32x4*)(gain + 32 * bj + 8 * fq + 4 * n);
            float rf[2][4];
#pragma unroll
            for (int n = 0; n < 2; ++n)
#pragma unroll
                for (int e = 0; e < 4; ++e) { const int i = 8 * fq + 4 * n + e; rf[n][e] = __builtin_amdgcn_exp2f(-(float)i * (13.287712379549449f / 32.0f)) * 0.15915494309189535f; }
            const int colb = (pn & 1) * 256 + 64 * wc + 8 * fq;
#pragma unroll
            for (int ai = 0; ai < 2; ++ai)
#pragma unroll
                for (int m = 0; m < 4; ++m) {
                    const int row = rowt + ai * HALF + m * 16;
                    const int itok = row & 2047;
                    const size_t orow = isq ? (size_t)row : (size_t)(row >> 11) * KROWS + itok;
                    float ss = 0.f;
#pragma unroll
                    for (int bj = 0; bj < 2; ++bj)
#pragma unroll
                        for (int n = 0; n < 2; ++n) { const f32x4 x = acc[ai][bj][m][n]; ss += (x[0] * x[0] + x[1] * x[1]) + (x[2] * x[2] + x[3] * x[3]); }
                    ss += __shfl_xor(ss, 16); ss += __shfl_xor(ss, 32);
                    const float rs = __builtin_amdgcn_rsqf(ss * (dsc * dsc * (1.0f / 64.0f)) + 1e-6f) * osc * dsc;
                    f32x4 y[2][2];
#pragma unroll
                    for (int bj = 0; bj < 2; ++bj)
#pragma unroll
                        for (int n = 0; n < 2; ++n) y[bj][n] = acc[ai][bj][m][n] * gv[bj][n] * rs;
                    if (isdiff) {
                        const float pos = (float)(16 + itok);
#pragma unroll
                        for (int n = 0; n < 2; ++n)
#pragma unroll
                            for (int e = 0; e < 4; ++e) {
                                float rev = pos * rf[n][e]; rev = __builtin_amdgcn_fractf(rev);
                                const float c = __builtin_amdgcn_cosf(rev), s = __builtin_amdgcn_sinf(rev);
                                const float x1 = y[0][n][e], x2 = y[1][n][e];
                                y[0][n][e] = x1 * c - x2 * s; y[1][n][e] = x2 * c + x1 * s;
                            }
                    }
#pragma unroll
                    for (int bj = 0; bj < 2; ++bj) {
                        u32x4 w; w.x = cvt_pk_bf16(y[bj][0][0], y[bj][0][1]); w.y = cvt_pk_bf16(y[bj][0][2], y[bj][0][3]); w.z = cvt_pk_bf16(y[bj][1][0], y[bj][1][1]); w.w = cvt_pk_bf16(y[bj][1][2], y[bj][1][3]);
                        *(u32x4*)(outp + orow * 512 + colb + 32 * bj) = w;
                    }
                }
        } else if (pn < 12) {
            bf16_t* outp = (bf16_t*)(ws + (pn < 6 ? WS_DV : WS_FV));
            const int colb = (pn & 1) * 256 + 32 * wc + 8 * fq;
#pragma unroll
            for (int ai = 0; ai < 2; ++ai)
#pragma unroll
                for (int m = 0; m < 4; ++m) {
                    const int row = rowt + ai * HALF + m * 16;
                    const size_t orow = (size_t)(row >> 11) * KROWS + (row & 2047);
#pragma unroll
                    for (int bj = 0; bj < 2; ++bj) {
                        const f32x4 v0 = acc[ai][bj][m][0] * dsc, v1 = acc[ai][bj][m][1] * dsc;
                        u32x4 w; w.x = cvt_pk_bf16(v0[0], v0[1]); w.y = cvt_pk_bf16(v0[2], v0[3]); w.z = cvt_pk_bf16(v1[0], v1[1]); w.w = cvt_pk_bf16(v1[2], v1[3]);
                        *(u32x4*)(outp + orow * 512 + colb + HALF * bj) = w;
                    }
                }
        } else {
            const bool isb = pn >= 16;
            unsigned char* outp = ws + (isb ? WS_GB : WS_GA);
            const int colb = ((pn - 12) & 3) * 256 + 32 * wc + 8 * fq;
            const PG8_LAS float* bp = bgate + (isb ? 1024 : 0) + colb;
            f32x4 bv[2][2];
#pragma unroll
            for (int bj = 0; bj < 2; ++bj)
#pragma unroll
                for (int n = 0; n < 2; ++n) bv[bj][n] = *(const PG8_LAS f32x4*)(bp + HALF * bj + 4 * n);
#pragma unroll
            for (int ai = 0; ai < 2; ++ai)
#pragma unroll
                for (int m = 0; m < 4; ++m) {
                    const size_t row = (size_t)(rowt + ai * HALF + m * 16);
#pragma unroll
                    for (int bj = 0; bj < 2; ++bj) {
                        f32x4 v0 = acc[ai][bj][m][0] * dsc + bv[bj][0], v1 = acc[ai][bj][m][1] * dsc + bv[bj][1];
#pragma unroll
                        for (int e = 0; e < 4; ++e) { v0[e] = __builtin_rintf(255.0f * __builtin_amdgcn_rcpf(1.0f + __builtin_amdgcn_exp2f(-1.4426950408889634f * v0[e]))); v1[e] = __builtin_rintf(255.0f * __builtin_amdgcn_rcpf(1.0f + __builtin_amdgcn_exp2f(-1.4426950408889634f * v1[e]))); }
                        u32x2 w; unsigned p0 = 0u, p1 = 0u;
                        p0 = __builtin_amdgcn_cvt_pk_u8_f32(v0[0], 0, p0); p0 = __builtin_amdgcn_cvt_pk_u8_f32(v0[1], 1, p0); p0 = __builtin_amdgcn_cvt_pk_u8_f32(v0[2], 2, p0); p0 = __builtin_amdgcn_cvt_pk_u8_f32(v0[3], 3, p0);
                        p1 = __builtin_amdgcn_cvt_pk_u8_f32(v1[0], 0, p1); p1 = __builtin_amdgcn_cvt_pk_u8_f32(v1[1], 1, p1); p1 = __builtin_amdgcn_cvt_pk_u8_f32(v1[2], 2, p1); p1 = __builtin_amdgcn_cvt_pk_u8_f32(v1[3], 3, p1);
                        w.x = p0; w.y = p1;
                        *(u32x2*)(outp + row * 1024 + colb + HALF * bj) = w;
                    }
                }
        }
    }
};

template <bool SECOND> struct EpiGateT {
    static constexpr bool PERM = true, AFTER_DRAIN = false;
    static constexpr float sc8 = 32.0f, dsc = 1.0f / (16.0f * 256.0f);
    unsigned char* ws;
    __device__ __forceinline__ void operator()(const f32x4 (&acc)[2][2][4][2], const Unit& u, int wr, int wc, int fr_in, int fq_in) const {
        int fr = fr_in, fq = fq_in; asm volatile("" : "+v"(fr), "+v"(fq));
        const unsigned char* gate = ws + (SECOND ? WS_GB : WS_GA); const bf16_t* prev = (const bf16_t*)(ws + WS_TMP); bf16_t* out = (bf16_t*)(ws + WS_TMP); unsigned char* out8 = SECOND ? ws + WS_MERGED : nullptr;
        const int rowt = u.pm * BM + wr * 64 + fr, colb = u.pn * BM + 32 * wc + 8 * fq;
        constexpr bool hp = SECOND;
        constexpr int DEP = SECOND ? 4 : 8;
        u32x2 gq[DEP][2]; u32x4 pq[DEP][2];
#define EG_OFF(s) ((size_t)(rowt + ((s) >> 2) * HALF + ((s) & 3) * 16) * 1024 + colb)
#define EG_LOAD(G, P, s) do { const size_t o_ = EG_OFF(s); G[0] = *(const u32x2*)(gate + o_); G[1] = *(const u32x2*)(gate + o_ + HALF); if (hp) { P[0] = *(const u32x4*)(prev + o_); P[1] = *(const u32x4*)(prev + o_ + HALF); } } while (0)
#pragma unroll
        for (int d = 0; d < DEP; ++d) EG_LOAD(gq[d], pq[d], d);
#pragma unroll
        for (int s = 0; s < 8; ++s) {
            const int ai = s >> 2, m = s & 3, qd = s % DEP; const size_t off = EG_OFF(s);
#pragma unroll
            for (int bj = 0; bj < 2; ++bj) {
                const u32x2 g = gq[qd][bj]; const unsigned g0 = g.x, g1 = g.y;
                const f32x4 a0 = acc[ai][bj][m][0], a1 = acc[ai][bj][m][1];
                constexpr float dg = dsc * (1.0f / 255.0f);
                float o[8] = {a0[0] * dg * (float)(g0 & 0xffu), a0[1] * dg * (float)((g0 >> 8) & 0xffu), a0[2] * dg * (float)((g0 >> 16) & 0xffu), a0[3] * dg * (float)(g0 >> 24),
                              a1[0] * dg * (float)(g1 & 0xffu), a1[1] * dg * (float)((g1 >> 8) & 0xffu), a1[2] * dg * (float)((g1 >> 16) & 0xffu), a1[3] * dg * (float)(g1 >> 24)};
                if (hp) { const u32x4 p = pq[qd][bj];
                    o[0] += bf_lo(p.x); o[1] += bf_hi(p.x); o[2] += bf_lo(p.y); o[3] += bf_hi(p.y); o[4] += bf_lo(p.z); o[5] += bf_hi(p.z); o[6] += bf_lo(p.w); o[7] += bf_hi(p.w); }
                if constexpr (SECOND) { u32x2 w8; w8.x = cvt_pk4_fp8(o[0] * sc8, o[1] * sc8, o[2] * sc8, o[3] * sc8); w8.y = cvt_pk4_fp8(o[4] * sc8, o[5] * sc8, o[6] * sc8, o[7] * sc8);
                    *(u32x2*)(out8 + off + HALF * bj) = w8; }
                else { u32x4 w; w.x = cvt_pk_bf16(o[0], o[1]); w.y = cvt_pk_bf16(o[2], o[3]); w.z = cvt_pk_bf16(o[4], o[5]); w.w = cvt_pk_bf16(o[6], o[7]);
                    *(u32x4*)(out + off + HALF * bj) = w; }
            }
            if (s + DEP < 8) EG_LOAD(gq[qd], pq[qd], s + DEP);
        }
#undef EG_LOAD
#undef EG_OFF
    }
};

struct EpiGatePair {
    static constexpr bool PERM = true, AFTER_DRAIN = false;
    unsigned char* ws;
    __device__ __forceinline__ void operator()(const f32x4 (&acc)[2][2][4][2], const Unit& u, int wr, int wc, int fr_in, int fq_in) const {
        if (u.sel) { const EpiGateT<true> e{ws}; e(acc, u, wr, wc, fr_in, fq_in); } else { const EpiGateT<false> e{ws}; e(acc, u, wr, wc, fr_in, fq_in); }
    }
};

struct EpiMix {
    static constexpr bool PERM = true, AFTER_DRAIN = false;
    const float* x; float* out; bf16_t* h1b; float* ssqp; float dsc;
    __device__ __forceinline__ void operator()(const f32x4 (&acc)[2][2][4][2], const Unit& u, int wr, int wc, int fr_in, int fq_in) const {
        int fr = fr_in, fq = fq_in; asm volatile("" : "+v"(fr), "+v"(fq));
        const int rowt = u.pm * BM + wr * 64 + fr, colb = u.pn * BM + 32 * wc + 8 * fq;
        f32x4 xq[4][4];
#define EM_ROW(s) (rowt + ((s) >> 2) * HALF + ((s) & 3) * 16)
#define EM_LOAD(X, s) do { const float* p_ = x + (size_t)EM_ROW(s) * 1024 + colb; X[0] = *(const f32x4*)(p_); X[1] = *(const f32x4*)(p_ + 4); X[2] = *(const f32x4*)(p_ + HALF); X[3] = *(const f32x4*)(p_ + HALF + 4); } while (0)
#pragma unroll
        for (int d = 0; d < 4; ++d) EM_LOAD(xq[d], d);
#pragma unroll
        for (int s = 0; s < 8; ++s) {
            const int ai = s >> 2, m = s & 3, qd = s & 3; const int row = EM_ROW(s);
            const size_t off = (size_t)row * 1024 + colb;
            float ss = 0.f;
#pragma unroll
            for (int bj = 0; bj < 2; ++bj) {
                const f32x4 h0 = xq[qd][2 * bj] + acc[ai][bj][m][0] * dsc, h1 = xq[qd][2 * bj + 1] + acc[ai][bj][m][1] * dsc;
                if (out) { *(f32x4*)(out + off + HALF * bj) = h0; *(f32x4*)(out + off + HALF * bj + 4) = h1; }
                ss += (h0[0] * h0[0] + h0[1] * h0[1]) + (h0[2] * h0[2] + h0[3] * h0[3]) + (h1[0] * h1[0] + h1[1] * h1[1]) + (h1[2] * h1[2] + h1[3] * h1[3]);
                u32x4 w; w.x = cvt_pk_bf16(h0[0], h0[1]); w.y = cvt_pk_bf16(h0[2], h0[3]); w.z = cvt_pk_bf16(h1[0], h1[1]); w.w = cvt_pk_bf16(h1[2], h1[3]);
                *(u32x4*)(h1b + off + HALF * bj) = w;
            }
            ss += __shfl_xor(ss, 16); ss += __shfl_xor(ss, 32);
            if (fq == 0) ssqp[(size_t)row * 16 + u.pn * 4 + wc] = ss;
            if (s + 4 < 8) EM_LOAD(xq[qd], s + 4);
        }
#undef EM_LOAD
#undef EM_ROW
    }
};

__device__ __forceinline__ u32x4 dpp_ror8(const u32x4 v) {
    u32x4 r; r.x = (unsigned)__builtin_amdgcn_update_dpp(0, (int)v.x, 0x128, 0xf, 0xf, true); r.y = (unsigned)__builtin_amdgcn_update_dpp(0, (int)v.y, 0x128, 0xf, 0xf, true);
    r.z = (unsigned)__builtin_amdgcn_update_dpp(0, (int)v.z, 0x128, 0xf, 0xf, true); r.w = (unsigned)__builtin_amdgcn_update_dpp(0, (int)v.w, 0x128, 0xf, 0xf, true); return r;
}
struct EpiQ2 {
    static constexpr bool PERM = true, AFTER_DRAIN = false;
    bf16_t* q2; float dsc;
    __device__ __forceinline__ void operator()(const f32x4 (&acc)[2][2][4][2], const Unit& u, int wr, int wc, int fr_in, int fq_in) const {
        int fr = fr_in, fq = fq_in; asm volatile("" : "+v"(fr), "+v"(fq));
        const bool lo = fr < 8;
        const int rowt = u.pm * BM + wr * 64 + (fr & 7), colb = u.pn * BM + 64 * wc + 8 * fq + (lo ? 0 : 32);
#pragma unroll
        for (int ai = 0; ai < 2; ++ai)
#pragma unroll
            for (int m = 0; m < 4; ++m) {
                const int row = rowt + ai * HALF + m * 16;
                u32x4 d[2];
#pragma unroll
                for (int bj = 0; bj < 2; ++bj) {
                    const f32x4 v0 = acc[ai][bj][m][0] * dsc, v1 = acc[ai][bj][m][1] * dsc;
                    d[bj].x = cvt_pk_bf16(v0[0], v0[1]); d[bj].y = cvt_pk_bf16(v0[2], v0[3]); d[bj].z = cvt_pk_bf16(v1[0], v1[1]); d[bj].w = cvt_pk_bf16(v1[2], v1[3]);
                }
                u32x4 snd; snd.x = lo ? d[1].x : d[0].x; snd.y = lo ? d[1].y : d[0].y; snd.z = lo ? d[1].z : d[0].z; snd.w = lo ? d[1].w : d[0].w;
                const u32x4 rcv = dpp_ror8(snd);
                u32x4 w1, w2;
                w1.x = lo ? d[0].x : rcv.x; w1.y = lo ? d[0].y : rcv.y; w1.z = lo ? d[0].z : rcv.z; w1.w = lo ? d[0].w : rcv.w;
                w2.x = lo ? rcv.x : d[1].x; w2.y = lo ? rcv.y : d[1].y; w2.z = lo ? rcv.z : d[1].z; w2.w = lo ? rcv.w : d[1].w;
                *(u32x4*)(q2 + (size_t)row * 2048 + colb) = w1;
                *(u32x4*)(q2 + (size_t)(row + 8) * 2048 + colb) = w2;
            }
    }
};
typedef int pg8_v8i __attribute__((ext_vector_type(8)));
typedef int pg8_v4i __attribute__((ext_vector_type(4)));
__device__ __forceinline__ pg8_v8i pg8_cat(const bf16x8 a, const bf16x8 b) { const pg8_v4i x = __builtin_bit_cast(pg8_v4i, a), y = __builtin_bit_cast(pg8_v4i, b); return __builtin_shufflevector(x, y, 0, 1, 2, 3, 4, 5, 6, 7); }
template <class E_> constexpr auto pg8_prio3(int) -> decltype(E_::PRIO3) { return E_::PRIO3; }
template <class E_> constexpr bool pg8_prio3(long) { return false; }
template <class Epi, class Sched, bool ALIGN_EPI = false, bool SP2 = false, bool F8 = false>
__device__ __forceinline__ void gemm_phase(int wv  , PG8_LAS unsigned char* lds, const Gemm g, const Sched& S, const Epi& E) {
    int tid_ = wv * 64 + mk_lane(); asm volatile("" : "+v"(tid_));
    const int tid = tid_, wid = wv, lane = tid & 63, wr = wid >> 2, wc = wid & 3, fr = lane & 15, fq = lane >> 4;
    const int K = g.K, nt = K / BK;
    unsigned voffA[2], voffB[2];
#pragma unroll
    for (int i = 0; i < 2; ++i) { int R, C; stage_rc(tid * 16 + i * 8192, R, C); const int Rb = Epi::PERM ? ((R & ~31) + perm32(R & 31)) : R;
        voffA[i] = (unsigned)(R * K + C) * 2u; voffB[i] = (unsigned)(Rb * K + C) * 2u; }
    const size_t kstep = (size_t)(BK * 2);
    const size_t hstep = (size_t)HALF * K * 2;
    const size_t tstep = 2 * hstep;
    const unsigned ldsw = (unsigned)wid * 1024u;
    const int aoff = lds_byte(wr * 64 + fr, fq * 8), boff = lds_byte(wc * 32 + fr, fq * 8);
#define PG8_SA(b, h) (((b) * 2 + (h)) * HTB)
#define PG8_SB(b, h) ((4 + (b) * 2 + (h)) * HTB)
#define PG8_STAGE(bufoff, gbase, voff) do { _Pragma("unroll") for (int _i = 0; _i < 2; ++_i) \
        __builtin_amdgcn_global_load_lds((const unsigned*)((const char*)(gbase) + (voff)[_i]), (PG8_LAS unsigned*)(lds + (bufoff) + ldsw + _i * 8192), 16, 0, 0); } while (0)
#define PG8_LDA(dst, b, h) do { _Pragma("unroll") for (int m = 0; m < 4; ++m) { const bf16x8 l0_ = *(const PG8_LAS bf16x8*)(lds + PG8_SA(b, h) + aoff + m * 2048), l1_ = *(const PG8_LAS bf16x8*)(lds + PG8_SA(b, h) + aoff + m * 2048 + 1024); \
        if constexpr (F8) dst##8[m] = pg8_cat(l0_, l1_); else { dst[m][0] = l0_; dst[m][1] = l1_; } } } while (0)
#define PG8_LDB(dst, b, h) do { _Pragma("unroll") for (int n = 0; n < 2; ++n) { const bf16x8 l0_ = *(const PG8_LAS bf16x8*)(lds + PG8_SB(b, h) + boff + n * 2048), l1_ = *(const PG8_LAS bf16x8*)(lds + PG8_SB(b, h) + boff + n * 2048 + 1024); \
        if constexpr (F8) dst##8[n] = pg8_cat(l0_, l1_); else { dst[n][0] = l0_; dst[n][1] = l1_; } } } while (0)
#define PG8_MMA(ai, bj, At, Bt) do { if constexpr (pg8_prio3<Epi>(0)) __builtin_amdgcn_s_setprio(3); else __builtin_amdgcn_s_setprio(1);     \
        if constexpr (F8) { _Pragma("unroll") for (int m = 0; m < 4; ++m) _Pragma("unroll") for (int n = 0; n < 2; ++n) \
        acc[ai][bj][m][n] = __builtin_amdgcn_mfma_scale_f32_16x16x128_f8f6f4(Bt##8[n], At##8[m], acc[ai][bj][m][n], 0, 0, 0, 0x7f7f7f7f, 0, 0x7f7f7f7f); \
        asm volatile("" : "+v"(acc[ai][bj][0][0]), "+v"(acc[ai][bj][0][1]), "+v"(acc[ai][bj][1][0]), "+v"(acc[ai][bj][1][1]), "+v"(acc[ai][bj][2][0]), "+v"(acc[ai][bj][2][1]), "+v"(acc[ai][bj][3][0]), "+v"(acc[ai][bj][3][1]));   } else { \
        _Pragma("unroll") for (int m = 0; m < 4; ++m) _Pragma("unroll") for (int n = 0; n < 2; ++n) _Pragma("unroll") for (int k = 0; k < 2; ++k) \
        acc[ai][bj][m][n] = __builtin_amdgcn_mfma_f32_16x16x32_bf16(Bt[n][k], At[m][k], acc[ai][bj][m][n], 0, 0, 0); } __builtin_amdgcn_s_setprio(0); } while (0)
#define PG8_WAIT_V(n) asm volatile("s_waitcnt vmcnt(" #n ")" ::: "memory")
#define PG8_WAIT_L(n) asm volatile("s_waitcnt lgkmcnt(" #n ")" ::: "memory")
#define PG8_BAR __builtin_amdgcn_s_barrier()
#define PG8_SCHED __builtin_amdgcn_sched_barrier(0)
    Unit cur, nxt; int ui = 0;
    if (!S.next(0, cur)) return;
    f32x4 acc[2][2][4][2];
#pragma unroll
    for (int a = 0; a < 2; ++a)
#pragma unroll
        for (int b = 0; b < 2; ++b)
#pragma unroll
            for (int m = 0; m < 4; ++m)
#pragma unroll
                for (int n = 0; n < 2; ++n) { acc[a][b][m][n] = (f32x4){0.f, 0.f, 0.f, 0.f}; }
    bf16x8 At[4][2], B0[2][2], B1[2][2]; pg8_v8i At8[4], B08[2], B18[2];
    const char* cA = (const char*)(cur.sel ? g.A2 : g.A) + (size_t)cur.pm * tstep; const char* cB = (const char*)(cur.sel ? g.Bt2 : g.Bt) + (size_t)cur.pn * tstep;
    S.a_ready(cur);
    if constexpr (SP2) {
        PG8_STAGE(PG8_SB(0, 0), cB, voffB); PG8_STAGE(PG8_SB(0, 1), cB + hstep, voffB); PG8_STAGE(PG8_SA(0, 0), cA, voffA); PG8_STAGE(PG8_SA(0, 1), cA + hstep, voffA);
        if (wr == 1) PG8_BAR;
        PG8_WAIT_V(2); PG8_BAR;
        PG8_STAGE(PG8_SB(1, 0), cB + kstep, voffB); PG8_STAGE(PG8_SA(1, 0), cA + kstep, voffA); PG8_STAGE(PG8_SB(1, 1), cB + hstep + kstep, voffB);
        PG8_WAIT_V(6); PG8_BAR;
    } else {
        PG8_STAGE(PG8_SB(0, 0), cB, voffB); PG8_STAGE(PG8_SA(0, 0), cA, voffA); PG8_STAGE(PG8_SB(0, 1), cB + hstep, voffB); PG8_STAGE(PG8_SA(0, 1), cA + hstep, voffA);
        if (wr == 1) PG8_BAR;
        PG8_WAIT_V(4); PG8_BAR;
        PG8_STAGE(PG8_SB(1, 0), cB + kstep, voffB); PG8_STAGE(PG8_SA(1, 0), cA + kstep, voffA); PG8_STAGE(PG8_SB(1, 1), cB + hstep + kstep, voffB);
        PG8_WAIT_V(6); PG8_BAR;
    }
    for (;;) {
        const bool has_next = S.next(ui + 1, nxt);
        const char* nA = has_next ? (const char*)(nxt.sel ? g.A2 : g.A) + (size_t)nxt.pm * tstep : cA; const char* nB = has_next ? (const char*)(nxt.sel ? g.Bt2 : g.Bt) + (size_t)nxt.pn * tstep : cB;
#pragma nounroll
        for (int t = 0; t < nt; t += 2) {
            asm volatile("" : "+v"(voffA[0]), "+v"(voffA[1]), "+v"(voffB[0]), "+v"(voffB[1]));
            const bool last = (t == nt - 2);
            const char* a1 = cA + (size_t)(t + 1) * kstep;
            const char* a2 = last ? nA : cA + (size_t)(t + 2) * kstep; const char* b2 = last ? nB : cB + (size_t)(t + 2) * kstep;
            const char* a3 = a2 + kstep; const char* b3 = b2 + kstep;
            if (last && has_next) S.a_ready(nxt);
            if constexpr (SP2) {
            PG8_LDB(B0, 0, 0); PG8_LDB(B1, 0, 1); PG8_SCHED; PG8_LDA(At, 0, 0); PG8_STAGE(PG8_SA(1, 1), a1 + hstep, voffA);
            PG8_WAIT_V(8); PG8_WAIT_L(0); PG8_BAR; PG8_MMA(0, 0, At, B0); PG8_MMA(0, 1, At, B1); PG8_BAR; PG8_SCHED;
            PG8_LDA(At, 0, 1); PG8_STAGE(PG8_SB(0, 0), b2, voffB); PG8_STAGE(PG8_SB(0, 1), b2 + hstep, voffB); PG8_STAGE(PG8_SA(0, 0), a2, voffA);
            PG8_WAIT_V(8); PG8_WAIT_L(0); PG8_BAR; PG8_MMA(1, 0, At, B0); PG8_MMA(1, 1, At, B1); PG8_BAR; PG8_SCHED;
            PG8_LDB(B0, 1, 0); PG8_LDB(B1, 1, 1); PG8_SCHED; PG8_LDA(At, 1, 0); PG8_STAGE(PG8_SA(0, 1), a2 + hstep, voffA);
            PG8_WAIT_V(8); PG8_WAIT_L(0); PG8_BAR; PG8_MMA(0, 0, At, B0); PG8_MMA(0, 1, At, B1); PG8_BAR; PG8_SCHED;
            PG8_LDA(At, 1, 1); PG8_STAGE(PG8_SB(1, 0), b3, voffB); PG8_STAGE(PG8_SB(1, 1), b3 + hstep, voffB); PG8_STAGE(PG8_SA(1, 0), a3, voffA);
            PG8_WAIT_V(8); PG8_WAIT_L(0); PG8_BAR; PG8_MMA(1, 0, At, B0); PG8_MMA(1, 1, At, B1); PG8_BAR; PG8_SCHED;
            } else {
            PG8_LDB(B0, 0, 0); PG8_SCHED; PG8_LDA(At, 0, 0); PG8_STAGE(PG8_SA(1, 1), a1 + hstep, voffA);
            PG8_WAIT_L(8); PG8_BAR; PG8_WAIT_L(0); PG8_MMA(0, 0, At, B0); PG8_BAR; PG8_SCHED;
            PG8_LDB(B1, 0, 1); PG8_STAGE(PG8_SB(0, 0), b2, voffB);
            PG8_BAR; PG8_WAIT_L(0); PG8_MMA(0, 1, At, B1); PG8_BAR;
            PG8_LDA(At, 0, 1); PG8_STAGE(PG8_SA(0, 0), a2, voffA);
            PG8_BAR; PG8_WAIT_L(0); PG8_MMA(1, 0, At, B0); PG8_BAR; PG8_SCHED;
            PG8_STAGE(PG8_SB(0, 1), b2 + hstep, voffB);
            PG8_WAIT_V(6); PG8_BAR; PG8_MMA(1, 1, At, B1); PG8_BAR;
            PG8_LDB(B0, 1, 0); PG8_SCHED; PG8_LDA(At, 1, 0); PG8_STAGE(PG8_SA(0, 1), a2 + hstep, voffA);
            PG8_WAIT_L(8); PG8_BAR; PG8_WAIT_L(0); PG8_MMA(0, 0, At, B0); PG8_BAR; PG8_SCHED;
            PG8_LDB(B1, 1, 1); PG8_STAGE(PG8_SB(1, 0), b3, voffB);
            PG8_BAR; PG8_WAIT_L(0); PG8_MMA(0, 1, At, B1); PG8_BAR;
            PG8_LDA(At, 1, 1); PG8_STAGE(PG8_SA(1, 0), a3, voffA);
            PG8_BAR; PG8_WAIT_L(0); PG8_MMA(1, 0, At, B0); PG8_BAR; PG8_SCHED;
            PG8_STAGE(PG8_SB(1, 1), b3 + hstep, voffB);
            PG8_WAIT_V(6); PG8_BAR; PG8_MMA(1, 1, At, B1); PG8_BAR;
            }
        }
        if constexpr (ALIGN_EPI) { if (wr == 0) PG8_BAR; }
        if constexpr (!Epi::AFTER_DRAIN) { E(acc, cur, wr, wc, fr, fq); S.done(cur); }
        if (!has_next) break;
#pragma unroll
        for (int a = 0; a < 2; ++a)
#pragma unroll
            for (int b = 0; b < 2; ++b)
#pragma unroll
                for (int m = 0; m < 4; ++m)
#pragma unroll
                    for (int n = 0; n < 2; ++n) { acc[a][b][m][n] = (f32x4){0.f, 0.f, 0.f, 0.f}; }
        cur = nxt; cA = nA; cB = nB; ++ui;
        if constexpr (ALIGN_EPI) { if (wr == 1) PG8_BAR; }
    }
    PG8_WAIT_V(0);
    if constexpr (!ALIGN_EPI) { if (wr == 0) PG8_BAR; }
    PG8_BAR;
    if constexpr (Epi::AFTER_DRAIN) { E.fused(acc, cur, wr, wc, fr, fq, lds, wid, lane); S.done(cur); }
#undef PG8_SA
#undef PG8_SB
#undef PG8_STAGE
#undef PG8_LDA
#undef PG8_LDB
#undef PG8_MMA
#undef PG8_WAIT_V
#undef PG8_WAIT_L
#undef PG8_BAR
#undef PG8_SCHED
}
}
#include <hip/hip_bf16.h>
#include <cmath>
namespace attn_body {
using bf16=__hip_bfloat16;
using bf16x8=__attribute__((ext_vector_type(8)))short;
using s16x4=__attribute__((ext_vector_type(4)))short;
using f32x16=__attribute__((ext_vector_type(16)))float;
using u32x4=__attribute__((ext_vector_type(4)))unsigned;
typedef float f32x4_t __attribute__((ext_vector_type(4)));
constexpr int D=64,PQKV=512;
constexpr int NW=8,QBLK=32,QB=QBLK*NW,KVBLK=64;
constexpr int ATTN_UNIT_ROWS=QB;
__device__ __forceinline__ int crow(int r,int hi){return (r&3)+8*(r>>2)+4*hi;}
#define SBAR() __builtin_amdgcn_sched_barrier(0)
__device__ __forceinline__ void cmask(f32x16&p0,f32x16&p1,int jb,int qrel,int hi){
  const float NEG=-INFINITY; int kb=64*jb+4*hi;
  #pragma unroll
  for(int r=0;r<16;++r){int kv=kb+(r&3)+8*(r>>2); if(kv>qrel)p0[r]=NEG; if(kv+32>qrel)p1[r]=NEG;}
}

__device__ __forceinline__ void mask_all(f32x16&p0,f32x16&p1){const float NEG=-INFINITY;
  #pragma unroll
  for(int r=0;r<16;++r){p0[r]=NEG;p1[r]=NEG;}}
__device__ __forceinline__ void mask_meta(f32x16&p0,f32x16&p1){const float NEG=-INFINITY;
  #pragma unroll
  for(int r=8;r<16;++r)p0[r]=NEG;
  #pragma unroll
  for(int r=0;r<16;++r)p1[r]=NEG;}
constexpr int NSLOT=3, SLOTB=8192;
constexpr int LDS_K=0, LDS_V=NSLOT*SLOTB, LDS_WS=2*NSLOT*SLOTB, LDS_OST=LDS_WS+NW*64*4, LDS_BIAS=LDS_OST+NW*4096, LDS_ST=LDS_BIAS+34*64*4, LDS_BYTES=LDS_ST+NW*64*4;
constexpr float C2=0.125f*1.4426950408889634f;
__device__ __forceinline__ void glds16(const void*gsrc,unsigned lds_dst){unsigned keep;
  asm volatile("s_mov_b32 %0, m0\n\ts_mov_b32 m0, %2\n\ts_nop 0\n\tglobal_load_lds_dwordx4 %1, off\n\ts_mov_b32 m0, %0":"=&s"(keep):"v"(gsrc),"s"(lds_dst):"memory");}
__device__ __forceinline__ float max3f(float a,float b,float c){float r;asm("v_max3_f32 %0, %1, %2, %3":"=v"(r):"v"(a),"v"(b),"v"(c));return r;}
__device__ __forceinline__ float max2f(float a,float b){float r;asm("v_max_f32_e32 %0, %1, %2":"=v"(r):"v"(a),"v"(b));return r;}
__device__ __forceinline__ float fadd_s(float a,float b){float r;asm("v_add_f32_e32 %0, %1, %2":"=v"(r):"v"(a),"v"(b));return r;}
__device__ __forceinline__ float fsub_s(float a,float b){float r;asm("v_sub_f32_e32 %0, %1, %2":"=v"(r):"v"(a),"v"(b));return r;}
typedef float f32x2_t __attribute__((ext_vector_type(2))); typedef __bf16 bf16x2_t __attribute__((ext_vector_type(2)));
__device__ __forceinline__ unsigned cvtpk_s(float lo,float hi){f32x2_t v={lo,hi};bf16x2_t b=__builtin_convertvector(v,bf16x2_t);return __builtin_bit_cast(unsigned,b);}
#define WAIT_BAR(N) asm volatile("s_waitcnt vmcnt(" #N ") lgkmcnt(0)\n\ts_barrier":::"memory")

__device__ __forceinline__ void qkt(f32x16&p0,f32x16&p1,const char*Kslot,const bf16x8*qr,const f32x16&negm,int r32,int hi){
  const char*kb=Kslot+hi*1024+r32*16;
  #pragma unroll
  for(int d0=0;d0<4;++d0){
    const bf16x8 b0=*reinterpret_cast<const bf16x8*>(kb+d0*2048);
    const bf16x8 b1=*reinterpret_cast<const bf16x8*>(kb+d0*2048+512);
    if(d0==0){p0=__builtin_amdgcn_mfma_f32_32x32x16_bf16(b0,qr[0],negm,0,0,0);p1=__builtin_amdgcn_mfma_f32_32x32x16_bf16(b1,qr[0],negm,0,0,0);}
    else{p0=__builtin_amdgcn_mfma_f32_32x32x16_bf16(b0,qr[d0],p0,0,0,0);p1=__builtin_amdgcn_mfma_f32_32x32x16_bf16(b1,qr[d0],p1,0,0,0);}}
}
typedef __attribute__((address_space(3))) const char* lds_cptr;
typedef short v4i16_t __attribute__((ext_vector_type(4)));
__device__ __forceinline__ void kload8(bf16x8*kf,lds_cptr kp){
  kf[0]=*(const __attribute__((address_space(3))) bf16x8*)(kp);      kf[1]=*(const __attribute__((address_space(3))) bf16x8*)(kp+512);
  kf[2]=*(const __attribute__((address_space(3))) bf16x8*)(kp+2048); kf[3]=*(const __attribute__((address_space(3))) bf16x8*)(kp+2560);
  kf[4]=*(const __attribute__((address_space(3))) bf16x8*)(kp+4096); kf[5]=*(const __attribute__((address_space(3))) bf16x8*)(kp+4608);
  kf[6]=*(const __attribute__((address_space(3))) bf16x8*)(kp+6144); kf[7]=*(const __attribute__((address_space(3))) bf16x8*)(kp+6656);
}
__device__ __forceinline__ void kload2(bf16x8*kf,lds_cptr kp,int j){ kf[2*j]=*(const __attribute__((address_space(3))) bf16x8*)(kp+j*2048); kf[2*j+1]=*(const __attribute__((address_space(3))) bf16x8*)(kp+j*2048+512); }
__device__ __forceinline__ s16x4 vtr(lds_cptr p){ return __builtin_bit_cast(s16x4,__builtin_amdgcn_ds_read_tr16_b64_v4i16((__attribute__((address_space(3))) v4i16_t*)p)); }
__device__ __forceinline__ float rowmax(const f32x16&p0,const f32x16&p1){
  float a=max3f(p0[0],p0[1],p1[0]),b=max3f(p0[2],p0[3],p1[1]);a=max3f(a,p1[2],p1[3]);
  #pragma unroll
  for(int r=4;r<16;r+=4){a=max3f(a,p0[r],p0[r+1]);b=max3f(b,p0[r+2],p0[r+3]);a=max3f(a,p1[r],p1[r+1]);b=max3f(b,p1[r+2],p1[r+3]);}
  const float m=max2f(a,b);
  auto rr=__builtin_amdgcn_permlane32_swap(__float_as_uint(m),__float_as_uint(m),false,false);
  return max2f(__uint_as_float(rr[0]),__uint_as_float(rr[1]));
}
__device__ __forceinline__ void pv(f32x16*o,int vb,bf16x8 pa0,bf16x8 pa1,bf16x8 pa2,bf16x8 pa3){
  #pragma unroll
  for(int d0=0;d0<2;++d0){s16x4 lo[4],hi[4];
    #pragma unroll
    for(int ks=0;ks<4;++ks){
      asm volatile("ds_read_b64_tr_b16 %0,%1 offset:%c2":"=&v"(lo[ks]):"v"(vb),"i"(d0*4096+ks*1024):"memory");
      asm volatile("ds_read_b64_tr_b16 %0,%1 offset:%c2":"=&v"(hi[ks]):"v"(vb),"i"(d0*4096+ks*1024+512):"memory");}
    asm volatile("s_waitcnt lgkmcnt(0)":::"memory");SBAR();
    #define PK(k) (bf16x8){lo[k][0],lo[k][1],lo[k][2],lo[k][3],hi[k][0],hi[k][1],hi[k][2],hi[k][3]}
    o[d0]=__builtin_amdgcn_mfma_f32_32x32x16_bf16(pa0,PK(0),o[d0],0,0,0);
    o[d0]=__builtin_amdgcn_mfma_f32_32x32x16_bf16(pa1,PK(1),o[d0],0,0,0);
    o[d0]=__builtin_amdgcn_mfma_f32_32x32x16_bf16(pa2,PK(2),o[d0],0,0,0);
    o[d0]=__builtin_amdgcn_mfma_f32_32x32x16_bf16(pa3,PK(3),o[d0],0,0,0);
    #undef PK
  }
}

#ifndef ATTN_STORE16
#define ATTN_STORE16(p,v) (*(u32x4*)(p)=(v))
#endif
template<int THRL,bool FOX,bool KN=false> __device__ __forceinline__ void attn_unit(int wv,int qb,const bf16*Qb,const bf16*__restrict__ Kb,const bf16*__restrict__ Vb,bf16*Ob,int OP,const float*__restrict__ cbv,char*shm){
  const int tid=wv*64+mk_lane_v(),lane=tid&63,r32=lane&31,hi=lane>>5; const int wid=wv;
  const int q0=qb*QB; constexpr int DM=PQKV;
  const bf16*Qw=Qb+(long)(wid*QBLK)*DM;
  const bf16*Kh=Kb,*Vh=Vb;
  const unsigned lds0=(unsigned)(uintptr_t)shm;
  float*wsf=(float*)(shm+LDS_WS)+wid*64;
  const bf16*ksrc=Kh+(long)lane*DM+wid*8;
  const bf16*vsrc=Vh+(long)(16*(wid&3)+(lane>>2))*DM+(wid>>2)*32+(lane&3)*8;
  const unsigned kdst=lds0+LDS_K+wid*1024, vdst=lds0+LDS_V+wid*1024;
  #define TROW(t) (((t)==0)?2048:64*((t)-1))
  #define DMA_K(t,slot) glds16(ksrc+(long)TROW(t)*DM,(unsigned)__builtin_amdgcn_readfirstlane(kdst+(slot)))
  #define DMA_V(t,slot) glds16(vsrc+(long)TROW(t)*DM,(unsigned)__builtin_amdgcn_readfirstlane(vdst+(slot)))
  const int vb0=(int)(lds0+LDS_V)+((lane>>4)&1)*32+(lane&3)*8+(4*hi+((lane&15)>>2))*64;
  const char*Kbase=shm+LDS_K; bf16x8 kf[8];
  const lds_cptr shm3=(lds_cptr)shm; const lds_cptr kp0=shm3+LDS_K+hi*1024+r32*16; const lds_cptr vp0=shm3+LDS_V+((lane>>4)&1)*32+(lane&3)*8+(4*hi+((lane&15)>>2))*64;
  const int NT=4*qb+5;
  float*biasL=(float*)(shm+LDS_BIAS);
  if(FOX){ const float ref=cbv[q0]; for(int e=tid;e<NT*64;e+=NW*64){const int t_=e>>6,k_=e&63; biasL[e]=cbv[TROW(t_)+k_]-ref;} }
  asm volatile("s_waitcnt vmcnt(0) lgkmcnt(0)\n\ts_barrier":::"memory");
  const __attribute__((address_space(3))) float* bl3=(const __attribute__((address_space(3))) float*)(lds_cptr)shm + (LDS_BIAS>>2) + 4*hi;
  #define LOADCB(t,H) do{ if(FOX){ _Pragma("unroll") for(int g_=0;g_<4;++g_){ \
      const f32x4_t u0=*(const __attribute__((address_space(3))) f32x4_t*)(bl3+(t)*64+32*(H)+8*g_); \
      negm[4*g_]=u0[0]-mhat;negm[4*g_+1]=u0[1]-mhat;negm[4*g_+2]=u0[2]-mhat;negm[4*g_+3]=u0[3]-mhat; } \
      asm volatile("":"+v"(negm)); } }while(0)
  #define ADDB(P,t,H) do{ _Pragma("unroll") for(int g_=0;g_<4;++g_){ const f32x4_t u0=*(const __attribute__((address_space(3))) f32x4_t*)(bl3+(t)*64+32*(H)+8*g_); P[4*g_]+=u0[0];P[4*g_+1]+=u0[1];P[4*g_+2]+=u0[2];P[4*g_+3]+=u0[3]; } }while(0)
  DMA_K(0,0);DMA_V(0,0);DMA_K(1,SLOTB);
  bf16x8 qr[4];
  #pragma unroll
  for(int d0=0;d0<4;++d0)qr[d0]=*reinterpret_cast<const bf16x8*>(&Qw[(long)r32*DM+d0*16+hi*8]);
  float mhat=0.f,l_reg=0.f;f32x16 o[2];o[0]=f32x16{};o[1]=f32x16{};f32x16 negm=f32x16{};asm volatile("":"+v"(negm));
  float*stw=(float*)(shm+LDS_ST)+wid*64;
  if(KN){ mhat=stw[r32]; l_reg=stw[32+r32]; asm volatile("s_waitcnt lgkmcnt(0)":::"memory"); _Pragma("unroll") for(int r=0;r<16;++r)negm[r]=-mhat; asm volatile("":"+v"(negm)); }
  const int qrel=wid*QBLK+r32;
  #define CMASK(P0,P1,t) do{int jb_=(t)-(NT-4); if(jb_>=0){ if(FOX)cmask(P0,P1,jb_,qrel,hi); else if(jb_>(wid>>1))mask_all(P0,P1);} }while(0)
  bool resc=false;
  #define START(P0,P1) do{ resc=false; \
    if(!KN){ const float rm=rowmax(P0,P1); const float dl=rm; mhat=fadd_s(mhat,dl); \
      _Pragma("unroll") for(int r=0;r<16;++r){P0[r]=fsub_s(P0[r],dl);P1[r]=fsub_s(P1[r],dl);} \
      if(!FOX){_Pragma("unroll") for(int r=0;r<16;++r)negm[r]=-mhat; asm volatile("":"+v"(negm));} } \
    _Pragma("unroll") for(int r=0;r<16;++r)P0[r]=__builtin_amdgcn_exp2f(P0[r]); }while(0)
  #define RESC() do{ if(resc){ asm volatile("s_waitcnt lgkmcnt(0)":::"memory"); \
      _Pragma("unroll") for(int d_=0;d_<2;++d_) _Pragma("unroll") for(int r=0;r<16;++r)o[d_][r]*=wsf[crow(r,hi)]; } }while(0)
  f32x16 pA0,pA1,pB0,pB1;
  int sl_prev=0,sl_cur=0,sl_next=SLOTB;
  #define ROT() do{sl_prev=sl_cur;sl_cur=sl_next;sl_next=(sl_next==(NSLOT-1)*SLOTB)?0:sl_next+SLOTB;}while(0)
  DMA_K(2,2*SLOTB);
  WAIT_BAR(3);
  qkt(pA0,pA1,Kbase,qr,negm,r32,hi);asm volatile("s_nop 15\n\ts_nop 7":"+v"(pA0),"+v"(pA1)); if(FOX){ADDB(pA0,0,0);ADDB(pA1,0,1);} mask_meta(pA0,pA1);
  START(pA0,pA1);
  _Pragma("unroll") for(int r=0;r<16;++r)pA1[r]=__builtin_amdgcn_exp2f(pA1[r]);
  WAIT_BAR(0);
  DMA_K(3,0);DMA_V(1,SLOTB);
  ROT();
  kload8(kf,kp0+sl_cur);
  WAIT_BAR(2);
  s16x4 vlo[8],vhi[8]; u32x4 pw0,pw1,pw2,pw3;
  #define PKW(P,B) cvtpk_s(P[B],P[B+1])
  #define PAF(k) __builtin_bit_cast(bf16x8,pw##k)
  #define VFR(i) (bf16x8){vlo[i][0],vlo[i][1],vlo[i][2],vlo[i][3],vhi[i][0],vhi[i][1],vhi[i][2],vhi[i][3]}
  #define PIN(x) asm volatile("":"+v"(x))
  #define MX3(a,b,c) __builtin_fmaxf(__builtin_fmaxf((a),(b)),(c))
  #define GAPA(MF,A0,A1,A2,A3,W0,W1,PW) do{ MF; if(!KN){sacc+=A0; sacc+=A1; sacc+=A2; sacc+=A3; PIN(sacc);} W0; W1; PIN(PW); SBAR(); }while(0)
  #define EX(v) __builtin_amdgcn_exp2f(v)
  #define GAPB(MF,X,B) do{ MF; X[B]=EX(X[B]); X[B+1]=EX(X[B+1]); X[B+2]=EX(X[B+2]); X[B+3]=EX(X[B+3]); PIN(X); SBAR(); }while(0)
  #define VRD(i) do{ vlo[i]=vtr(vp_+(((i)>>2)*4096+((i)&3)*1024)); vhi[i]=vtr(vp_+(((i)>>2)*4096+((i)&3)*1024+512)); }while(0)
  #define KRD(G,j) do{ if(G){ kload2(kf,kp0+sl_next,j); SBAR(); } }while(0)
  #define STEP(C0,C1,P0,P1,t,GK,GV,GL) do{ SBAR(); LOADCB(t,0); SBAR(); \
    const lds_cptr vp_=vp0+sl_prev; \
    VRD(0); SBAR(); float sacc=(P0[0]+P0[1]); \
    GAPA(C0=__builtin_amdgcn_mfma_f32_32x32x16_bf16(kf[0],qr[0],negm,0,0,0), P0[2],P0[3],P0[4],P0[5],     pw0[0]=PKW(P0,0), pw0[1]=PKW(P0,2), pw0); \
    VRD(4); SBAR(); LOADCB(t,1); SBAR(); GAPA(C1=__builtin_amdgcn_mfma_f32_32x32x16_bf16(kf[1],qr[0],negm,0,0,0), P0[6],P0[7],P0[8],P0[9],     pw0[2]=PKW(P0,4), pw0[3]=PKW(P0,6), pw0); \
    VRD(1); SBAR(); GAPA(C0=__builtin_amdgcn_mfma_f32_32x32x16_bf16(kf[2],qr[1],C0,0,0,0),   P0[10],P0[11],P0[12],P0[13], pw1[0]=PKW(P0,8), pw1[1]=PKW(P0,10), pw1); \
    VRD(5); SBAR(); GAPA(C1=__builtin_amdgcn_mfma_f32_32x32x16_bf16(kf[3],qr[1],C1,0,0,0),   P0[14],P0[15],P1[0],P1[1],   pw1[2]=PKW(P0,12),pw1[3]=PKW(P0,14), pw1); \
    VRD(2); SBAR(); GAPA(C0=__builtin_amdgcn_mfma_f32_32x32x16_bf16(kf[4],qr[2],C0,0,0,0),   P1[2],P1[3],P1[4],P1[5],     pw2[0]=PKW(P1,0), pw2[1]=PKW(P1,2), pw2); \
    VRD(6); SBAR(); GAPA(C1=__builtin_amdgcn_mfma_f32_32x32x16_bf16(kf[5],qr[2],C1,0,0,0),   P1[6],P1[7],P1[8],P1[9],     pw2[2]=PKW(P1,4), pw2[3]=PKW(P1,6), pw2); \
    VRD(3); SBAR(); GAPA(C0=__builtin_amdgcn_mfma_f32_32x32x16_bf16(kf[6],qr[3],C0,0,0,0),   P1[10],P1[11],P1[12],P1[13], pw3[0]=PKW(P1,8), pw3[1]=PKW(P1,10), pw3); \
    VRD(7); SBAR(); GAPA(C1=__builtin_amdgcn_mfma_f32_32x32x16_bf16(kf[7],qr[3],C1,0,0,0),   P1[14],P1[15],0.f,0.f,       pw3[2]=PKW(P1,12),pw3[3]=PKW(P1,14), pw3); \
    if(!KN)l_reg+=sacc; \
    if(GK){DMA_K((t)+3,sl_cur);} if(GV){DMA_V((t)+1,sl_next);} \
    CMASK(C0,C1,t); \
    if(!KN){ float a=MX3(C0[0],C0[1],C1[0]),b=MX3(C0[2],C0[3],C1[1]); a=MX3(a,C1[2],C1[3]); \
      _Pragma("unroll") for(int r=4;r<16;r+=4){a=MX3(a,C0[r],C0[r+1]);b=MX3(b,C0[r+2],C0[r+3]);a=MX3(a,C1[r],C1[r+1]);b=MX3(b,C1[r+2],C1[r+3]);} \
      float rm=__builtin_fmaxf(a,b); { auto rr=__builtin_amdgcn_permlane32_swap(__float_as_uint(rm),__float_as_uint(rm),false,false); rm=__builtin_fmaxf(__uint_as_float(rr[0]),__uint_as_float(rr[1])); } \
      resc=false; \
      if(__builtin_expect(__any(rm>(float)THRL),0)){ const float dl=__builtin_fmaxf(rm,0.f); mhat+=dl; \
        _Pragma("unroll") for(int r=0;r<16;++r){C0[r]-=dl;C1[r]-=dl;} \
        if(!FOX){_Pragma("unroll") for(int r=0;r<16;++r)negm[r]=-mhat; asm volatile("":"+v"(negm));} \
        const float f=__builtin_amdgcn_exp2f(-dl); l_reg*=f; if(hi==0)wsf[r32]=f; resc=true; } } \
    SBAR(); \
    GAPB(o[0]=__builtin_amdgcn_mfma_f32_32x32x16_bf16(PAF(0),VFR(0),o[0],0,0,0), C0,0); \
    GAPB(o[1]=__builtin_amdgcn_mfma_f32_32x32x16_bf16(PAF(0),VFR(4),o[1],0,0,0), C0,4); \
    KRD(GL,0); GAPB(o[0]=__builtin_amdgcn_mfma_f32_32x32x16_bf16(PAF(1),VFR(1),o[0],0,0,0), C0,8); \
    KRD(GL,1); GAPB(o[1]=__builtin_amdgcn_mfma_f32_32x32x16_bf16(PAF(1),VFR(5),o[1],0,0,0), C0,12); \
    KRD(GL,2); GAPB(o[0]=__builtin_amdgcn_mfma_f32_32x32x16_bf16(PAF(2),VFR(2),o[0],0,0,0), C1,0); \
    KRD(GL,3); GAPB(o[1]=__builtin_amdgcn_mfma_f32_32x32x16_bf16(PAF(2),VFR(6),o[1],0,0,0), C1,4); \
    GAPB(o[0]=__builtin_amdgcn_mfma_f32_32x32x16_bf16(PAF(3),VFR(3),o[0],0,0,0), C1,8); \
    GAPB(o[1]=__builtin_amdgcn_mfma_f32_32x32x16_bf16(PAF(3),VFR(7),o[1],0,0,0), C1,12); \
    }while(0)
  int t=1;
  #undef CMASK
  #define CMASK(P0,P1,t) do{}while(0)
  for(;t+5<NT;t+=2){
    STEP(pB0,pB1,pA0,pA1,t,true,true,true);     WAIT_BAR(2); RESC(); ROT();
    STEP(pA0,pA1,pB0,pB1,t+1,true,true,true);   WAIT_BAR(2); RESC(); ROT();
  }
  #undef CMASK
  #define CMASK(P0,P1,t) do{int jb_=(t)-(NT-4); if(jb_>=0){ if(FOX)cmask(P0,P1,jb_,qrel,hi); else if(jb_>(wid>>1))mask_all(P0,P1);} }while(0)
  #define ENDW(tt) do{ if((tt)+3<NT){WAIT_BAR(2);} else if((tt)+2<NT){WAIT_BAR(1);} else {WAIT_BAR(0);} }while(0)
  for(;t+3<NT;t+=2){
    STEP(pB0,pB1,pA0,pA1,t,(t+3<NT),(t+1<NT),(t+1<NT));       ENDW(t);   RESC(); ROT();
    STEP(pA0,pA1,pB0,pB1,t+1,(t+4<NT),(t+2<NT),(t+2<NT));     ENDW(t+1); RESC(); ROT();
  }
  STEP(pB0,pB1,pA0,pA1,t,(t+3<NT),(t+1<NT),(t+1<NT));         ENDW(t);   RESC(); ROT();
  STEP(pA0,pA1,pB0,pB1,NT-1,false,false,false); RESC();
  { float sacc=pA0[0]+pA0[1]; _Pragma("unroll") for(int r=2;r<16;++r)sacc+=pA0[r]; _Pragma("unroll") for(int r=0;r<16;++r)sacc+=pA1[r]; if(!KN)l_reg+=sacc;
    pw0=(u32x4){PKW(pA0,0),PKW(pA0,2),PKW(pA0,4),PKW(pA0,6)};pw1=(u32x4){PKW(pA0,8),PKW(pA0,10),PKW(pA0,12),PKW(pA0,14)};pw2=(u32x4){PKW(pA1,0),PKW(pA1,2),PKW(pA1,4),PKW(pA1,6)};pw3=(u32x4){PKW(pA1,8),PKW(pA1,10),PKW(pA1,12),PKW(pA1,14)};
    SBAR(); pv(o,vb0+sl_cur,PAF(0),PAF(1),PAF(2),PAF(3)); }
  #undef PKW
  #undef PAF
  #undef VFR
  #undef PIN
  #undef MX3
  #undef GAPA
  #undef GAPB
  #undef EX
  #undef VRD
  #undef KRD
  #undef STEP
  #undef ENDW
  if(!KN){auto rr=__builtin_amdgcn_permlane32_swap(__float_as_uint(l_reg),__float_as_uint(l_reg),false,false);l_reg=__uint_as_float(rr[0])+__uint_as_float(rr[1]); if(!FOX&&hi==0){stw[r32]=mhat;stw[32+r32]=l_reg;} }
  if(hi==0)wsf[32+r32]=l_reg;asm volatile("s_waitcnt lgkmcnt(0)":::"memory");
  float rli[16];
  #pragma unroll
  for(int r=0;r<16;++r)rli[r]=__builtin_amdgcn_rcpf(wsf[32+crow(r,hi)]);
  bf16*Ow=Ob+(long)(wid*QBLK)*OP;
  if constexpr(FOX){ unsigned char*stg8=(unsigned char*)(shm+LDS_OST)+wid*4096;
    #pragma unroll
    for(int r=0;r<16;++r){const int orow=crow(r,hi); const float sc=rli[r]*16.0f;
      #pragma unroll
      for(int d0=0;d0<2;++d0){const float ov=o[d0][r]*sc; stg8[orow*64+d0*32+r32]=(unsigned char)(__builtin_amdgcn_cvt_pk_fp8_f32(ov,ov,0,false)&0xff);}}
    asm volatile("s_waitcnt lgkmcnt(0)":::"memory");
    unsigned char*Ow8=(unsigned char*)Ob+(long)(wid*QBLK)*OP;
    #pragma unroll
    for(int i=0;i<2;++i){const int row=i*16+(lane>>2),ch=lane&3; const u32x4 v=*(const u32x4*)(stg8+row*64+ch*16); ATTN_STORE16(Ow8+(long)row*OP+ch*16,v);} }
  else{ bf16*stg=(bf16*)(shm+LDS_OST)+wid*2048;
    #pragma unroll
    for(int r=0;r<16;++r){const int orow=crow(r,hi);
      #pragma unroll
      for(int d0=0;d0<2;++d0)stg[orow*64+d0*32+r32]=__float2bfloat16(o[d0][r]*rli[r]);}
    asm volatile("s_waitcnt lgkmcnt(0)":::"memory");
    #pragma unroll
    for(int i=0;i<4;++i){const int row=i*8+(lane>>3),ch=lane&7; const u32x4 v=*(const u32x4*)(stg+row*64+ch*8); ATTN_STORE16(Ow+(long)row*OP+ch*8,v);} }
  asm volatile("s_waitcnt lgkmcnt(0)\n\ts_barrier":::"memory");
  #undef DMA_K
  #undef TROW
  #undef LOADCB
  #undef ADDB
  #undef DMA_V
  #undef CMASK
  #undef START
  #undef RESC
  #undef ROT
}
constexpr int ATTN_LDS_BYTES=LDS_BYTES;
#undef SBAR
#undef WAIT_BAR
}
namespace attn_body {
constexpr int LDS_V2=LDS_ST+NW*64*4, LDS_BYTES_DV2=LDS_V2+NSLOT*SLOTB;
#define SBAR() __builtin_amdgcn_sched_barrier(0)
#define WAIT_BAR(N) asm volatile("s_waitcnt vmcnt(" #N ") lgkmcnt(0)\n\ts_barrier":::"memory")
template<int THRL,bool FOX,bool KN> __device__ __forceinline__ void attn_unit_dv2(int wv,int qb,const bf16*Qb,const bf16*__restrict__ Kb,const bf16*__restrict__ Vb,bf16*Ob,int OP,const float*__restrict__ cbv,char*shm){
  const int tid=wv*64+mk_lane_v(),lane=tid&63,r32=lane&31,hi=lane>>5; const int wid=wv;
  const int q0=qb*QB; constexpr int DM=PQKV;
  const bf16*Qw=Qb+(long)(wid*QBLK)*DM;
  const bf16*Kh=Kb,*Vh=Vb;
  const unsigned lds0=(unsigned)(uintptr_t)shm;
  float*wsf=(float*)(shm+LDS_WS)+wid*64;
  const bf16*ksrc=Kh+(long)lane*DM+wid*8;
  const bf16*vsrc=Vh+(long)(16*(wid&3)+(lane>>2))*DM+(wid>>2)*32+(lane&3)*8;
  const unsigned kdst=lds0+LDS_K+wid*1024, vdst=lds0+LDS_V+wid*1024, vdst2=lds0+LDS_V2+wid*1024;
  #define TROW(t) (((t)==0)?2048:64*((t)-1))
  #define DMA_K(t,slot) glds16(ksrc+(long)TROW(t)*DM,(unsigned)__builtin_amdgcn_readfirstlane(kdst+(slot)))
  #define DMA_V(t,slot) do{ glds16(vsrc+(long)TROW(t)*DM,(unsigned)__builtin_amdgcn_readfirstlane(vdst+(slot))); glds16(vsrc+64+(long)TROW(t)*DM,(unsigned)__builtin_amdgcn_readfirstlane(vdst2+(slot))); }while(0)
  const int vb0=(int)(lds0+LDS_V)+((lane>>4)&1)*32+(lane&3)*8+(4*hi+((lane&15)>>2))*64;
  const char*Kbase=shm+LDS_K; bf16x8 kf[8];
  const lds_cptr shm3=(lds_cptr)shm; const lds_cptr kp0=shm3+LDS_K+hi*1024+r32*16; const lds_cptr vp0=shm3+LDS_V+((lane>>4)&1)*32+(lane&3)*8+(4*hi+((lane&15)>>2))*64; const lds_cptr vp0b=vp0+(LDS_V2-LDS_V); const int vb0b=vb0+(LDS_V2-LDS_V);
  const int NT=4*qb+5;
  float*biasL=(float*)(shm+LDS_BIAS);
  if(FOX){ const float ref=cbv[q0]; for(int e=tid;e<NT*64;e+=NW*64){const int t_=e>>6,k_=e&63; biasL[e]=cbv[TROW(t_)+k_]-ref;} }
  asm volatile("s_waitcnt vmcnt(0) lgkmcnt(0)\n\ts_barrier":::"memory");
  const __attribute__((address_space(3))) float* bl3=(const __attribute__((address_space(3))) float*)(lds_cptr)shm + (LDS_BIAS>>2) + 4*hi;
  #define LOADCB(t,H) do{}while(0)
  #define ADDB(P,t,H) do{ _Pragma("unroll") for(int g_=0;g_<4;++g_){ const f32x4_t u0=*(const __attribute__((address_space(3))) f32x4_t*)(bl3+(t)*64+32*(H)+8*g_); P[4*g_]+=u0[0];P[4*g_+1]+=u0[1];P[4*g_+2]+=u0[2];P[4*g_+3]+=u0[3]; } }while(0)
  DMA_K(0,0);DMA_V(0,0);DMA_K(1,SLOTB);
  bf16x8 qr[4];
  #pragma unroll
  for(int d0=0;d0<4;++d0)qr[d0]=*reinterpret_cast<const bf16x8*>(&Qw[(long)r32*DM+d0*16+hi*8]);
  float mhat=0.f,l_reg=0.f;f32x16 o[4];o[0]=f32x16{};o[1]=f32x16{};o[2]=f32x16{};o[3]=f32x16{};const f32x16 zc=f32x16{};
  float*stw=(float*)(shm+LDS_ST)+wid*64;
  if(KN){ mhat=stw[r32]; l_reg=stw[32+r32]; asm volatile("s_waitcnt lgkmcnt(0)":::"memory"); }
  const int qrel=wid*QBLK+r32;
  #define CMASK(P0,P1,t) do{int jb_=(t)-(NT-4); if(jb_>=0){ if(FOX)cmask(P0,P1,jb_,qrel,hi); else if(jb_>(wid>>1))mask_all(P0,P1);} }while(0)
  bool resc=false;
  #define START(P0,P1) do{ resc=false; \
    if(!KN){ const float rm=rowmax(P0,P1); const float dl=rm; mhat=fadd_s(mhat,dl); \
      _Pragma("unroll") for(int r=0;r<16;++r){P0[r]=fsub_s(P0[r],dl);P1[r]=fsub_s(P1[r],dl);} \
      } \
    _Pragma("unroll") for(int r=0;r<16;++r)P0[r]=__builtin_amdgcn_exp2f(P0[r]); }while(0)
  #define RESC() do{ if(resc){ asm volatile("s_waitcnt lgkmcnt(0)":::"memory"); \
      _Pragma("unroll") for(int d_=0;d_<4;++d_) _Pragma("unroll") for(int r=0;r<16;++r)o[d_][r]*=wsf[crow(r,hi)]; } }while(0)
  f32x16 pA0,pA1,pB0,pB1;
  int sl_prev=0,sl_cur=0,sl_next=SLOTB;
  #define ROT() do{sl_prev=sl_cur;sl_cur=sl_next;sl_next=(sl_next==(NSLOT-1)*SLOTB)?0:sl_next+SLOTB;}while(0)
  DMA_K(2,2*SLOTB);
  WAIT_BAR(4);
  qkt(pA0,pA1,Kbase,qr,zc,r32,hi);asm volatile("s_nop 15\n\ts_nop 7":"+v"(pA0),"+v"(pA1)); if(FOX){ADDB(pA0,0,0);ADDB(pA1,0,1);} mask_meta(pA0,pA1);
  START(pA0,pA1);
  _Pragma("unroll") for(int r=0;r<16;++r)pA1[r]=__builtin_amdgcn_exp2f(pA1[r]);
  WAIT_BAR(0);
  DMA_K(3,0);DMA_V(1,SLOTB);
  ROT();
  kload8(kf,kp0+sl_cur);
  WAIT_BAR(3);
  s16x4 fl[4],fh[4]; u32x4 pw0,pw1,pw2,pw3;
  #define PKW(P,B) cvtpk_s(P[B],P[B+1])
  #define PAF(k) __builtin_bit_cast(bf16x8,pw##k)
  #define PIN(x) asm volatile("":"+v"(x))
  #define MX3(a,b,c) __builtin_fmaxf(__builtin_fmaxf((a),(b)),(c))
  #define GAPA(MF,A0,A1,A2,A3,W0,W1,PW) do{ MF; if(!KN){sacc+=A0; sacc+=A1; sacc+=A2; sacc+=A3; PIN(sacc);} W0; W1; PIN(PW); SBAR(); }while(0)
  #define EX(v) __builtin_amdgcn_exp2f(v)
  #define GAPB(MF,X,B) do{ MF; X[B]=EX(X[B]-mhat); X[B+1]=EX(X[B+1]-mhat); X[B+2]=EX(X[B+2]-mhat); X[B+3]=EX(X[B+3]-mhat); PIN(X); SBAR(); }while(0)
  #define KRD(G,j) do{ if(G){ kload2(kf,kp0+sl_next,j); SBAR(); } }while(0)
  #define STEP(C0,C1,P0,P1,t,GK,GV,GL) do{ SBAR(); LOADCB(t,0); SBAR(); \
    const lds_cptr vp_=vp0+sl_prev; const lds_cptr vp2_=vp0b+sl_prev; \
    float sacc=(P0[0]+P0[1]); \
    GAPA(C0=__builtin_amdgcn_mfma_f32_32x32x16_bf16(kf[0],qr[0],zc,0,0,0), P0[2],P0[3],P0[4],P0[5],     pw0[0]=PKW(P0,0), pw0[1]=PKW(P0,2), pw0); \
    LOADCB(t,1); SBAR(); GAPA(C1=__builtin_amdgcn_mfma_f32_32x32x16_bf16(kf[1],qr[0],zc,0,0,0), P0[6],P0[7],P0[8],P0[9],     pw0[2]=PKW(P0,4), pw0[3]=PKW(P0,6), pw0); \
    GAPA(C0=__builtin_amdgcn_mfma_f32_32x32x16_bf16(kf[2],qr[1],C0,0,0,0),   P0[10],P0[11],P0[12],P0[13], pw1[0]=PKW(P0,8), pw1[1]=PKW(P0,10), pw1); \
    GAPA(C1=__builtin_amdgcn_mfma_f32_32x32x16_bf16(kf[3],qr[1],C1,0,0,0),   P0[14],P0[15],P1[0],P1[1],   pw1[2]=PKW(P0,12),pw1[3]=PKW(P0,14), pw1); \
    GAPA(C0=__builtin_amdgcn_mfma_f32_32x32x16_bf16(kf[4],qr[2],C0,0,0,0),   P1[2],P1[3],P1[4],P1[5],     pw2[0]=PKW(P1,0), pw2[1]=PKW(P1,2), pw2); \
    GAPA(C1=__builtin_amdgcn_mfma_f32_32x32x16_bf16(kf[5],qr[2],C1,0,0,0),   P1[6],P1[7],P1[8],P1[9],     pw2[2]=PKW(P1,4), pw2[3]=PKW(P1,6), pw2); \
    GAPA(C0=__builtin_amdgcn_mfma_f32_32x32x16_bf16(kf[6],qr[3],C0,0,0,0),   P1[10],P1[11],P1[12],P1[13], pw3[0]=PKW(P1,8), pw3[1]=PKW(P1,10), pw3); \
    GAPA(C1=__builtin_amdgcn_mfma_f32_32x32x16_bf16(kf[7],qr[3],C1,0,0,0),   P1[14],P1[15],0.f,0.f,       pw3[2]=PKW(P1,12),pw3[3]=PKW(P1,14), pw3); \
    if(!KN)l_reg+=sacc; \
    if(GK){DMA_K((t)+3,sl_cur);} if(GV){DMA_V((t)+1,sl_next);} \
    SBAR(); fl[0]=vtr(vp_+0); fh[0]=vtr(vp_+512); fl[1]=vtr(vp_+4096); fh[1]=vtr(vp_+4608); SBAR(); \
    CMASK(C0,C1,t); \
    if(!KN){ float a=MX3(C0[0],C0[1],C1[0]),b=MX3(C0[2],C0[3],C1[1]); a=MX3(a,C1[2],C1[3]); \
      _Pragma("unroll") for(int r=4;r<16;r+=4){a=MX3(a,C0[r],C0[r+1]);b=MX3(b,C0[r+2],C0[r+3]);a=MX3(a,C1[r],C1[r+1]);b=MX3(b,C1[r+2],C1[r+3]);} \
      float rm=__builtin_fmaxf(a,b); { auto rr=__builtin_amdgcn_permlane32_swap(__float_as_uint(rm),__float_as_uint(rm),false,false); rm=__builtin_fmaxf(__uint_as_float(rr[0]),__uint_as_float(rr[1])); } \
      resc=false; rm-=mhat; \
      if(__builtin_expect(__any(rm>(float)THRL),0)){ const float dl=__builtin_fmaxf(rm,0.f); mhat+=dl; \
        const float f=__builtin_amdgcn_exp2f(-dl); l_reg*=f; if(hi==0)wsf[r32]=f; resc=true; } } \
    SBAR(); \
    GAPB(o[0]=__builtin_amdgcn_mfma_f32_32x32x16_bf16(PAF(0),(bf16x8){fl[0][0],fl[0][1],fl[0][2],fl[0][3],fh[0][0],fh[0][1],fh[0][2],fh[0][3]},o[0],0,0,0), C0,0); fl[2]=vtr(vp_+1024); fh[2]=vtr(vp_+1536); SBAR(); \
    GAPB(o[1]=__builtin_amdgcn_mfma_f32_32x32x16_bf16(PAF(0),(bf16x8){fl[1][0],fl[1][1],fl[1][2],fl[1][3],fh[1][0],fh[1][1],fh[1][2],fh[1][3]},o[1],0,0,0), C0,4); fl[3]=vtr(vp_+5120); fh[3]=vtr(vp_+5632); SBAR(); \
    KRD(GL,0); GAPB(o[0]=__builtin_amdgcn_mfma_f32_32x32x16_bf16(PAF(1),(bf16x8){fl[2][0],fl[2][1],fl[2][2],fl[2][3],fh[2][0],fh[2][1],fh[2][2],fh[2][3]},o[0],0,0,0), C0,8); fl[0]=vtr(vp_+2048); fh[0]=vtr(vp_+2560); SBAR(); \
    KRD(GL,1); GAPB(o[1]=__builtin_amdgcn_mfma_f32_32x32x16_bf16(PAF(1),(bf16x8){fl[3][0],fl[3][1],fl[3][2],fl[3][3],fh[3][0],fh[3][1],fh[3][2],fh[3][3]},o[1],0,0,0), C0,12); fl[1]=vtr(vp_+6144); fh[1]=vtr(vp_+6656); SBAR(); \
    KRD(GL,2); GAPB(o[0]=__builtin_amdgcn_mfma_f32_32x32x16_bf16(PAF(2),(bf16x8){fl[0][0],fl[0][1],fl[0][2],fl[0][3],fh[0][0],fh[0][1],fh[0][2],fh[0][3]},o[0],0,0,0), C1,0); fl[2]=vtr(vp_+3072); fh[2]=vtr(vp_+3584); SBAR(); \
    KRD(GL,3); GAPB(o[1]=__builtin_amdgcn_mfma_f32_32x32x16_bf16(PAF(2),(bf16x8){fl[1][0],fl[1][1],fl[1][2],fl[1][3],fh[1][0],fh[1][1],fh[1][2],fh[1][3]},o[1],0,0,0), C1,4); fl[3]=vtr(vp_+7168); fh[3]=vtr(vp_+7680); SBAR(); \
    GAPB(o[0]=__builtin_amdgcn_mfma_f32_32x32x16_bf16(PAF(3),(bf16x8){fl[2][0],fl[2][1],fl[2][2],fl[2][3],fh[2][0],fh[2][1],fh[2][2],fh[2][3]},o[0],0,0,0), C1,8); fl[0]=vtr(vp2_+0); fh[0]=vtr(vp2_+512); SBAR(); \
    GAPB(o[1]=__builtin_amdgcn_mfma_f32_32x32x16_bf16(PAF(3),(bf16x8){fl[3][0],fl[3][1],fl[3][2],fl[3][3],fh[3][0],fh[3][1],fh[3][2],fh[3][3]},o[1],0,0,0), C1,12); fl[1]=vtr(vp2_+4096); fh[1]=vtr(vp2_+4608); SBAR(); \
    o[2]=__builtin_amdgcn_mfma_f32_32x32x16_bf16(PAF(0),(bf16x8){fl[0][0],fl[0][1],fl[0][2],fl[0][3],fh[0][0],fh[0][1],fh[0][2],fh[0][3]},o[2],0,0,0); SBAR(); fl[2]=vtr(vp2_+1024); fh[2]=vtr(vp2_+1536); SBAR(); \
    o[3]=__builtin_amdgcn_mfma_f32_32x32x16_bf16(PAF(0),(bf16x8){fl[1][0],fl[1][1],fl[1][2],fl[1][3],fh[1][0],fh[1][1],fh[1][2],fh[1][3]},o[3],0,0,0); SBAR(); fl[3]=vtr(vp2_+5120); fh[3]=vtr(vp2_+5632); SBAR(); \
    o[2]=__builtin_amdgcn_mfma_f32_32x32x16_bf16(PAF(1),(bf16x8){fl[2][0],fl[2][1],fl[2][2],fl[2][3],fh[2][0],fh[2][1],fh[2][2],fh[2][3]},o[2],0,0,0); SBAR(); fl[0]=vtr(vp2_+2048); fh[0]=vtr(vp2_+2560); SBAR(); \
    o[3]=__builtin_amdgcn_mfma_f32_32x32x16_bf16(PAF(1),(bf16x8){fl[3][0],fl[3][1],fl[3][2],fl[3][3],fh[3][0],fh[3][1],fh[3][2],fh[3][3]},o[3],0,0,0); SBAR(); fl[1]=vtr(vp2_+6144); fh[1]=vtr(vp2_+6656); SBAR(); \
    o[2]=__builtin_amdgcn_mfma_f32_32x32x16_bf16(PAF(2),(bf16x8){fl[0][0],fl[0][1],fl[0][2],fl[0][3],fh[0][0],fh[0][1],fh[0][2],fh[0][3]},o[2],0,0,0); SBAR(); fl[2]=vtr(vp2_+3072); fh[2]=vtr(vp2_+3584); SBAR(); \
    o[3]=__builtin_amdgcn_mfma_f32_32x32x16_bf16(PAF(2),(bf16x8){fl[1][0],fl[1][1],fl[1][2],fl[1][3],fh[1][0],fh[1][1],fh[1][2],fh[1][3]},o[3],0,0,0); SBAR(); fl[3]=vtr(vp2_+7168); fh[3]=vtr(vp2_+7680); SBAR(); \
    o[2]=__builtin_amdgcn_mfma_f32_32x32x16_bf16(PAF(3),(bf16x8){fl[2][0],fl[2][1],fl[2][2],fl[2][3],fh[2][0],fh[2][1],fh[2][2],fh[2][3]},o[2],0,0,0); SBAR(); \
    o[3]=__builtin_amdgcn_mfma_f32_32x32x16_bf16(PAF(3),(bf16x8){fl[3][0],fl[3][1],fl[3][2],fl[3][3],fh[3][0],fh[3][1],fh[3][2],fh[3][3]},o[3],0,0,0); SBAR(); \
    }while(0)
  int t=1;
  #undef CMASK
  #define CMASK(P0,P1,t) do{}while(0)
  for(;t+5<NT;t+=2){
    STEP(pB0,pB1,pA0,pA1,t,true,true,true);     WAIT_BAR(3); RESC(); ROT();
    STEP(pA0,pA1,pB0,pB1,t+1,true,true,true);   WAIT_BAR(3); RESC(); ROT();
  }
  #undef CMASK
  #define CMASK(P0,P1,t) do{int jb_=(t)-(NT-4); if(jb_>=0){ if(FOX)cmask(P0,P1,jb_,qrel,hi); else if(jb_>(wid>>1))mask_all(P0,P1);} }while(0)
  #define ENDW(tt) do{ if((tt)+3<NT){WAIT_BAR(3);} else if((tt)+2<NT){WAIT_BAR(2);} else {WAIT_BAR(0);} }while(0)
  for(;t+3<NT;t+=2){
    STEP(pB0,pB1,pA0,pA1,t,(t+3<NT),(t+1<NT),(t+1<NT));       ENDW(t);   RESC(); ROT();
    STEP(pA0,pA1,pB0,pB1,t+1,(t+4<NT),(t+2<NT),(t+2<NT));     ENDW(t+1); RESC(); ROT();
  }
  STEP(pB0,pB1,pA0,pA1,t,(t+3<NT),(t+1<NT),(t+1<NT));         ENDW(t);   RESC(); ROT();
  STEP(pA0,pA1,pB0,pB1,NT-1,false,false,false); RESC();
  { float sacc=pA0[0]+pA0[1]; _Pragma("unroll") for(int r=2;r<16;++r)sacc+=pA0[r]; _Pragma("unroll") for(int r=0;r<16;++r)sacc+=pA1[r]; if(!KN)l_reg+=sacc;
    pw0=(u32x4){PKW(pA0,0),PKW(pA0,2),PKW(pA0,4),PKW(pA0,6)};pw1=(u32x4){PKW(pA0,8),PKW(pA0,10),PKW(pA0,12),PKW(pA0,14)};pw2=(u32x4){PKW(pA1,0),PKW(pA1,2),PKW(pA1,4),PKW(pA1,6)};pw3=(u32x4){PKW(pA1,8),PKW(pA1,10),PKW(pA1,12),PKW(pA1,14)};
    SBAR(); pv(o,vb0+sl_cur,PAF(0),PAF(1),PAF(2),PAF(3)); pv(o+2,vb0b+sl_cur,PAF(0),PAF(1),PAF(2),PAF(3)); }
  #undef PKW
  #undef PAF
  #undef PIN
  #undef MX3
  #undef GAPA
  #undef GAPB
  #undef EX
  #undef KRD
  #undef STEP
  #undef ENDW
  if(!KN){auto rr=__builtin_amdgcn_permlane32_swap(__float_as_uint(l_reg),__float_as_uint(l_reg),false,false);l_reg=__uint_as_float(rr[0])+__uint_as_float(rr[1]); if(!FOX&&hi==0){stw[r32]=mhat;stw[32+r32]=l_reg;} }
  if(hi==0)wsf[32+r32]=l_reg;asm volatile("s_waitcnt lgkmcnt(0)":::"memory");
  float rli[16];
  #pragma unroll
  for(int r=0;r<16;++r)rli[r]=__builtin_amdgcn_rcpf(wsf[32+crow(r,hi)]);
  bf16*Ow=Ob+(long)(wid*QBLK)*OP;
  { bf16*stg=(bf16*)(shm+LDS_OST)+wid*2048;
    #pragma unroll
    for(int hv=0;hv<2;++hv){
    #pragma unroll
    for(int r=0;r<16;++r){const int orow=crow(r,hi);
      #pragma unroll
      for(int d0=0;d0<2;++d0)stg[orow*64+d0*32+r32]=__float2bfloat16(o[2*hv+d0][r]*rli[r]);}
    asm volatile("s_waitcnt lgkmcnt(0)":::"memory");
    #pragma unroll
    for(int i=0;i<4;++i){const int row=i*8+(lane>>3),ch=lane&7; const u32x4 v=*(const u32x4*)(stg+row*64+ch*8); ATTN_STORE16(Ow+(long)row*OP+hv*64+ch*8,v);}
    asm volatile("s_waitcnt lgkmcnt(0)":::"memory"); } }
  asm volatile("s_waitcnt lgkmcnt(0)\n\ts_barrier":::"memory");
  #undef DMA_K
  #undef TROW
  #undef LOADCB
  #undef ADDB
  #undef DMA_V
  #undef CMASK
  #undef START
  #undef RESC
  #undef ROT
}
#undef SBAR
#undef WAIT_BAR
}
constexpr int NWAVES = 8;
constexpr int NB = 16, SEQ = 2048, DM_ = 1024, MROWS = NB * SEQ, NMETA = 16;
constexpr int INC = 5128, DK_OFF = 512, DV_OFF = 1024, FK_OFF = 2048, FV_OFF = 2560, FF_OFF = 3072;
constexpr int KROWS = pg8::KROWS;
constexpr float LOG2E = 1.4426950408889634f;
constexpr int N_PHASES = 12;
constexpr float SC_X = 16.f, SC_W = 256.f, SC_M = 32.f, SC_H = 16.f, SC_A = 16.f;

constexpr int RING_OFF = 0, RING_BYTES = 131072;
constexpr int LDSCTL_OFF = RING_BYTES, MISC_OFF = LDSCTL_OFF + 320;
constexpr int EPI_TAB_OFF = RING_BYTES + 1024;
constexpr int LDS_BYTES = 147456;

#define GAS __attribute__((address_space(1)))
#define LAS __attribute__((address_space(3)))
typedef unsigned short bf16;
typedef unsigned v4u __attribute__((ext_vector_type(4)));
typedef unsigned v2u __attribute__((ext_vector_type(2)));
typedef float f32x4 __attribute__((ext_vector_type(4)));
typedef GAS unsigned gu32;
typedef short bf16x8 __attribute__((ext_vector_type(8)));
#define RLX_AGENT __ATOMIC_RELAXED, __HIP_MEMORY_SCOPE_AGENT
#define LDS_WAIT() asm volatile("s_waitcnt lgkmcnt(0)" ::: "memory")
#define VM_WAIT() asm volatile("s_waitcnt vmcnt(0)" ::: "memory")
__device__ __forceinline__ unsigned pk2(float lo, float hi) { return pg8::cvt_pk_bf16(lo, hi); }


#define XB_TMO      128
#define XB_XCNT(j)  (256  + 64 * (j))
#define XB_XSUB(j)  (1280 + 64 * (j))
#define XB_XGEN(j)  (2304 + 64 * (j))
#define XB_TOP      3328
#define XB_TOPGEN   3392
#define XCD_BAR_WORDS 3456
#define XB_SPIN_CAP (1u << 18)

__device__ __forceinline__ unsigned xb_ld(unsigned* p)              { return __hip_atomic_load(p, __ATOMIC_RELAXED, __HIP_MEMORY_SCOPE_AGENT); }
__device__ __forceinline__ unsigned xb_add(unsigned* p, unsigned v) { return __hip_atomic_fetch_add(p, v, __ATOMIC_RELAXED, __HIP_MEMORY_SCOPE_AGENT); }
__device__ __forceinline__ unsigned xb_xcc_id() { return (unsigned)__builtin_amdgcn_s_getreg((3 << 11) | 20) & 0xFu; }
#define XB_SPIN(cond, bar) do { unsigned _sp = 0; while (cond) { __builtin_amdgcn_s_sleep(1); \
    if ((++_sp & 255u) == 0u) { if (xb_ld(&(bar)[XB_TMO])) break; if (_sp > XB_SPIN_CAP) { atomicAdd(&(bar)[XB_TMO], 1u); break; } } } } while (0)

struct XcdBarrier {
    unsigned* bar; unsigned x; int wv;
    volatile LAS unsigned* st;
};

__device__ __forceinline__ XcdBarrier xcd_barrier_post(unsigned* bar, volatile LAS unsigned* st) {
    XcdBarrier b; b.bar = bar; b.x = xb_xcc_id(); b.st = st;
    if (threadIdx.x == 0) st[2] = xb_add(&bar[XB_XCNT(b.x)], 1u);
    return b;
}
__device__ __forceinline__ void xcd_barrier_complete(unsigned* bar, unsigned x, unsigned& nloc, unsigned& nx) {
    const unsigned G = gridDim.x * gridDim.y * gridDim.z;
    unsigned sum, cnt, mine, sp = 0u;
    for (;;) {
        sum = 0u; cnt = 0u; mine = 0u;
#pragma unroll
        for (unsigned j = 0; j < 16; ++j) { const unsigned c = xb_ld(&bar[XB_XCNT(j)]); sum += c; cnt += (c > 0u) ? 1u : 0u; mine = (j == x) ? c : mine; }
        if (sum == G) break;
        __builtin_amdgcn_s_sleep(1);
        if ((++sp & 255u) == 0u) { if (xb_ld(&bar[XB_TMO])) break; if (sp > XB_SPIN_CAP) { atomicAdd(&bar[XB_TMO], 1u); break; } }
    }
    nloc = mine > 0u ? mine : 1u; nx = cnt > 0u ? cnt : 1u;
}

__device__ __forceinline__ void xcd_barrier(const XcdBarrier& b) {
    asm volatile("s_waitcnt vmcnt(0)" ::: "memory");
    __syncthreads();
    if (b.wv == 0 && mk_lane() == 0) {
        unsigned* bar = b.bar;
        __builtin_amdgcn_s_waitcnt(0);
        unsigned nloc = b.st[0], nx = b.st[1];
        if (nloc == 0u) { xcd_barrier_complete(bar, b.x, nloc, nx); b.st[0] = nloc; b.st[1] = nx;
            unsigned dense = 0u; for (unsigned j = 0; j < 16; ++j) if (j < b.x && xb_ld(&bar[XB_XCNT(j)]) > 0u) ++dense; b.st[3] = dense; }
        const unsigned old = xb_add(&bar[XB_XSUB(b.x)], 1u);
        const unsigned gen = old / nloc;
        if (old + 1u == (gen + 1u) * nloc) {
            __builtin_amdgcn_fence(__ATOMIC_RELEASE, "agent");
            asm volatile("s_waitcnt vmcnt(0)" ::: "memory");
            const unsigned og = xb_add(&bar[XB_TOP], 1u);
            const unsigned tg = og / nx;
            if (og + 1u == (tg + 1u) * nx) xb_add(&bar[XB_TOPGEN], 1u);
            else XB_SPIN(xb_ld(&bar[XB_TOPGEN]) == tg, bar);
            __builtin_amdgcn_fence(__ATOMIC_ACQUIRE, "agent");
            xb_add(&bar[XB_XGEN(b.x)], 1u);
            asm volatile("s_waitcnt vmcnt(0)" ::: "memory");
        } else {
            XB_SPIN(xb_ld(&bar[XB_XGEN(b.x)]) == gen, bar);
            __builtin_amdgcn_fence(__ATOMIC_ACQUIRE, "agent");
            asm volatile("s_waitcnt vmcnt(0)" ::: "memory");
        }
    }
    __syncthreads();
}


struct Frame {
    LAS unsigned char* lds;
    volatile LAS unsigned* MISC;
    gu32* ctl;
    int tid, lane, wave, vcu, G;
    const float *x, *meta, *gmix, *win, *bgate, *bforget, *dqg, *dkg, *dlam, *dsg, *fqg, *fkg, *wbd, *wbf, *wout, *gffn, *wq, *sk, *u, *v;
    float* out;
    unsigned char* ws;
};

template <int CTRL> __device__ __forceinline__ float dppx(float x) { return __builtin_amdgcn_update_dpp(0.f, x, CTRL, 0xf, 0xf, true); }
__device__ __forceinline__ float wave_sum(float v) {
    v += dppx<0xB1>(v); v += dppx<0x4E>(v); v += dppx<0x141>(v); v += dppx<0x128>(v);
    v += __shfl_xor(v, 16); v += __shfl_xor(v, 32);
    return v;
}
__device__ __forceinline__ float log_sigmoid(float z) { return -0.6931471805599453f * __builtin_amdgcn_logf(1.0f + __builtin_amdgcn_exp2f(-LOG2E * z)); }

__device__ __forceinline__ void p0_transpose_item(const float* W, int N, int nin0, const float* ks, bf16* WT, int K, int nout0, int k0, LAS float* scr, int lane) {
#pragma unroll 16
    for (int i = 0; i < 32; ++i) { const int kk = 2 * i + (lane >> 5); float w = W[(size_t)(k0 + kk) * N + nin0 + (lane & 31)]; if (ks) w *= ks[k0 + kk]; scr[kk * 33 + (lane & 31)] = w; }
    LDS_WAIT(); asm volatile("" ::: "memory");
    const int c = lane & 7;
#pragma unroll
    for (int j = 0; j < 4; ++j) { const int n = (lane >> 3) + 8 * j; const LAS float* s = scr + (8 * c) * 33 + n;
        v4u o; o.x = pk2(s[0 * 33], s[1 * 33]); o.y = pk2(s[2 * 33], s[3 * 33]); o.z = pk2(s[4 * 33], s[5 * 33]); o.w = pk2(s[6 * 33], s[7 * 33]);
        *(GAS v4u*)(WT + (size_t)(nout0 + n) * K + k0 + 8 * c) = o; }
    LDS_WAIT(); asm volatile("" ::: "memory");
}
__device__ __forceinline__ void p0_transpose8_item(const float* W, int N, int nin0, const float* ks, float scale, unsigned char* WT8, int K, int nout0, int k0, LAS float* scr, int lane) {
#pragma unroll 16
    for (int i = 0; i < 32; ++i) { const int kk = 2 * i + (lane >> 5); float w = W[(size_t)(k0 + kk) * N + nin0 + (lane & 31)] * scale; if (ks) w *= ks[k0 + kk]; scr[kk * 33 + (lane & 31)] = w; }
    LDS_WAIT(); asm volatile("" ::: "memory");
#pragma unroll
    for (int j = 0; j < 2; ++j) { const int task = lane + 64 * j, n = task >> 2, c = task & 3; const LAS float* s = scr + (16 * c) * 33 + n;
        v4u o; o.x = pg8::cvt_pk4_fp8(s[0 * 33], s[1 * 33], s[2 * 33], s[3 * 33]); o.y = pg8::cvt_pk4_fp8(s[4 * 33], s[5 * 33], s[6 * 33], s[7 * 33]);
        o.z = pg8::cvt_pk4_fp8(s[8 * 33], s[9 * 33], s[10 * 33], s[11 * 33]); o.w = pg8::cvt_pk4_fp8(s[12 * 33], s[13 * 33], s[14 * 33], s[15 * 33]);
        *(GAS v4u*)(WT8 + (size_t)(nout0 + n) * K + k0 + 16 * c) = o; }
    LDS_WAIT(); asm volatile("" ::: "memory");
}
__device__ __forceinline__ void p0_cvt_row(const float* src, bf16* dst, const float* cs, int lane) {
    const GAS f32x4* xr = (const GAS f32x4*)src + lane; GAS v2u* o8 = (GAS v2u*)dst + lane;
#pragma unroll
    for (int j = 0; j < 4; ++j) { f32x4 v = xr[64 * j]; if (cs) v = v * ((const GAS f32x4*)cs)[lane + 64 * j]; v2u w; w.x = pk2(v.x, v.y); w.y = pk2(v.z, v.w); o8[64 * j] = w; }
}

__device__ __forceinline__ void p0_meta(Frame& F, int j) {
    LAS float* hm = (LAS float*)F.lds;
    LAS float* red = hm + 16384;
    LAS float* res = red + 8192;
    const int tid = F.tid, lane = F.lane, wave = F.wave;
    for (int rr = 0; rr < 2; ++rr) {
        const int r = 2 * wave + rr; const GAS f32x4* mr = (const GAS f32x4*)(F.meta + (size_t)r * 1024) + lane;
        f32x4 v[4]; float ss = 0.f;
#pragma unroll
        for (int q = 0; q < 4; ++q) { v[q] = mr[64 * q]; ss += (v[q].x * v[q].x + v[q].y * v[q].y) + (v[q].z * v[q].z + v[q].w * v[q].w); }
        const float rs = 1.0f / sqrtf(wave_sum(ss) * (1.0f / 1024.0f) + 1e-6f);
#pragma unroll
        for (int q = 0; q < 4; ++q) { const int k = 4 * lane + 256 * q; const f32x4 g = ((const GAS f32x4*)F.gmix)[lane + 64 * q];
            hm[(k + 0) * 16 + r] = v[q].x * rs * g.x; hm[(k + 1) * 16 + r] = v[q].y * rs * g.y; hm[(k + 2) * 16 + r] = v[q].z * rs * g.z; hm[(k + 3) * 16 + r] = v[q].w * rs * g.w; }
    }
    __syncthreads();
    const int kind = j >> 3, gi = j & 7;
    const int c = tid & 63, s = tid >> 6;
    int col_in;
    if (kind == 0) col_in = DK_OFF + gi * 64 + c; else if (kind == 1) col_in = DV_OFF + gi * 64 + c; else if (kind == 2) col_in = FK_OFF + gi * 64 + c; else if (kind == 3) col_in = FV_OFF + gi * 64 + c; else col_in = FF_OFF + (c & 7);
    float acc[16];
#pragma unroll
    for (int r = 0; r < 16; ++r) acc[r] = 0.f;
    for (int k0 = 128 * s; k0 < 128 * s + 128; k0 += 64) {
        float wl[64];
#pragma unroll
        for (int u = 0; u < 64; ++u) wl[u] = F.win[(size_t)(k0 + u) * INC + col_in];
#pragma unroll
        for (int u = 0; u < 64; ++u) { const int k = k0 + u; const float w = wl[u];
        const LAS f32x4* hp = (const LAS f32x4*)(hm + k * 16);
        const f32x4 h0 = hp[0], h1 = hp[1], h2 = hp[2], h3 = hp[3];
        acc[0] += h0.x * w; acc[1] += h0.y * w; acc[2] += h0.z * w; acc[3] += h0.w * w; acc[4] += h1.x * w; acc[5] += h1.y * w; acc[6] += h1.z * w; acc[7] += h1.w * w;
        acc[8] += h2.x * w; acc[9] += h2.y * w; acc[10] += h2.z * w; acc[11] += h2.w * w; acc[12] += h3.x * w; acc[13] += h3.y * w; acc[14] += h3.z * w; acc[15] += h3.w * w;
        } }
#pragma unroll
    for (int r = 0; r < 16; ++r) red[(s * 16 + r) * 64 + c] = acc[r];
    __syncthreads();
    for (int o = tid; o < 1024; o += 512) { float t = 0.f;
#pragma unroll
        for (int q = 0; q < 8; ++q) t += red[q * 1024 + o];
        res[o] = t; }
    __syncthreads();
    const int r = tid >> 5, dlo = tid & 31;
    if (kind == 4) {
        if (dlo < 8) ((GAS float*)(F.ws + WS_LOGFM))[r * 8 + dlo] = log_sigmoid(res[r * 64 + dlo] + F.bforget[dlo]);
    } else {
        float y0 = res[r * 64 + dlo], y1 = res[r * 64 + dlo + 32];
        if (kind == 0 || kind == 2) {
            float ss = 0.f;
            for (int d = 0; d < 64; ++d) { const float t = res[r * 64 + d]; ss += t * t; }
            const float rs = 1.0f / sqrtf(ss * (1.0f / 64.0f) + 1e-6f);
            float g0, g1; if (kind == 0) { g0 = F.dkg[dlo]; g1 = F.dkg[dlo + 32]; } else { g0 = F.fkg[dlo]; g1 = F.fkg[dlo + 32]; }
            y0 *= rs * g0; y1 *= rs * g1;
            if (kind == 0) {
                const float invf = __builtin_amdgcn_exp2f(-(float)dlo * (13.287712379549449f / 32.0f));
                float rev = (float)r * invf * 0.15915494309189535f; rev = __builtin_amdgcn_fractf(rev);
                const float cs = __builtin_amdgcn_cosf(rev), sn = __builtin_amdgcn_sinf(rev);
                const float x1 = y0, x2 = y1; y0 = x1 * cs - x2 * sn; y1 = x2 * cs + x1 * sn;
            }
        }
        bf16* outp = (bf16*)(F.ws + (kind == 0 ? WS_DK : kind == 1 ? WS_DV : kind == 2 ? WS_FK : WS_FV));
        const unsigned short b0 = (unsigned short)(pk2(y0, 0.f) & 0xffffu), b1 = (unsigned short)(pk2(y1, 0.f) & 0xffffu);
        for (int b = 0; b < NB; ++b) { bf16* p = outp + ((size_t)b * KROWS + 2048 + r) * 512 + gi * 64; p[dlo] = b0; p[dlo + 32] = b1; }
        for (int o = tid; o < NB * 48 * 8; o += 512) { const int b = o / 384, rem = o % 384, pr = rem >> 3, ch = rem & 7;
            *(GAS v4u*)(outp + ((size_t)b * KROWS + 2064 + pr) * 512 + gi * 64 + ch * 8) = (v4u){0u, 0u, 0u, 0u}; }
    }
    __syncthreads();
}

struct P0Item { const float* W; const float* ks; unsigned char* WT; int N, nin0, K, nout0, k0; float scale; bool f8; };
__device__ __forceinline__ P0Item p0_item(Frame& F, int it) {
    constexpr int I_IN = 16 * 160, I_BD = 8 * 32, I_BF = 8 * 32, I_OUT = 16 * 32;
    P0Item d; int r = it;
    if (r < I_IN) { const int kb = r / 160, ob = r % 160, pn = ob >> 3, blk = ob & 7;
        const bool perm = (pn < 4) || (pn >= 6 && pn < 10);
        const int L0 = perm ? (256 * pn + 64 * (blk & 3) + 32 * (blk >> 2)) : (256 * pn + 32 * blk);
        d.W = F.win; d.ks = F.gmix; d.WT = F.ws + WS_WIN; d.N = INC; d.nin0 = L0 + (L0 >= 3072 ? 8 : 0); d.K = 1024; d.nout0 = 32 * ob; d.k0 = 64 * kb; d.scale = SC_W; d.f8 = true; return d; }
    r -= I_IN;
    if (r < I_BD) { d.W = F.wbd; d.ks = nullptr; d.WT = F.ws + WS_WBD; d.N = 1024; d.nin0 = 32 * (r % 32); d.K = 512; d.nout0 = 32 * (r % 32); d.k0 = 64 * (r / 32); d.scale = SC_W; d.f8 = true; return d; }
    r -= I_BD;
    if (r < I_BF) { d.W = F.wbf; d.ks = nullptr; d.WT = F.ws + WS_WBF; d.N = 1024; d.nin0 = 32 * (r % 32); d.K = 512; d.nout0 = 32 * (r % 32); d.k0 = 64 * (r / 32); d.scale = SC_W; d.f8 = true; return d; }
    r -= I_BF;
    if (r < I_OUT) { d.W = F.wout; d.ks = nullptr; d.WT = F.ws + WS_WOUT; d.N = 1024; d.nin0 = 32 * (r % 32); d.K = 1024; d.nout0 = 32 * (r % 32); d.k0 = 64 * (r / 32); d.scale = SC_W; d.f8 = true; return d; }
    r -= I_OUT;
    { const int ob = r % 64, blk = ob & 7; d.nin0 = 256 * (ob >> 3) + 64 * (blk & 3) + 32 * (blk >> 2); }
    d.W = F.wq; d.ks = F.gffn; d.WT = F.ws + WS_WQ; d.N = 2048; d.K = 1024; d.nout0 = 32 * (r % 64); d.k0 = 64 * (r / 64); d.scale = 1.0f; d.f8 = false; return d;
}
__device__ __forceinline__ void p0_item_load(const P0Item& d, float (&w)[32], int lane) {
#pragma unroll
    for (int i = 0; i < 32; ++i) { const int kk = 2 * i + (lane >> 5); w[i] = d.W[(size_t)(d.k0 + kk) * d.N + d.nin0 + (lane & 31)] * d.scale; if (d.ks) w[i] *= d.ks[d.k0 + kk]; }
}
__device__ __forceinline__ void p0_item_store(const P0Item& d, const float (&w)[32], LAS float* scr, int lane) {
#pragma unroll
    for (int i = 0; i < 32; ++i) { const int kk = 2 * i + (lane >> 5); scr[kk * 33 + (lane & 31)] = w[i]; }
    LDS_WAIT(); asm volatile("" ::: "memory");
    if (d.f8) {
#pragma unroll
        for (int j = 0; j < 2; ++j) { const int task = lane + 64 * j, n = task >> 2, c = task & 3; const LAS float* s = scr + (16 * c) * 33 + n;
            v4u o; o.x = pg8::cvt_pk4_fp8(s[0 * 33], s[1 * 33], s[2 * 33], s[3 * 33]); o.y = pg8::cvt_pk4_fp8(s[4 * 33], s[5 * 33], s[6 * 33], s[7 * 33]);
            o.z = pg8::cvt_pk4_fp8(s[8 * 33], s[9 * 33], s[10 * 33], s[11 * 33]); o.w = pg8::cvt_pk4_fp8(s[12 * 33], s[13 * 33], s[14 * 33], s[15 * 33]);
            *(GAS v4u*)(d.WT + (size_t)(d.nout0 + n) * d.K + d.k0 + 16 * c) = o; }
    } else {
        const int c = lane & 7;
#pragma unroll
        for (int j = 0; j < 4; ++j) { const int n = (lane >> 3) + 8 * j; const LAS float* s = scr + (8 * c) * 33 + n;
            v4u o; o.x = pk2(s[0 * 33], s[1 * 33]); o.y = pk2(s[2 * 33], s[3 * 33]); o.z = pk2(s[4 * 33], s[5 * 33]); o.w = pk2(s[6 * 33], s[7 * 33]);
            *(GAS v4u*)((bf16*)d.WT + (size_t)(d.nout0 + n) * d.K + d.k0 + 8 * c) = o; }
    }
    LDS_WAIT(); asm volatile("" ::: "memory");
}
__device__ __forceinline__ void p0_sec_transposes(Frame& F) {
    LAS float* scr = (LAS float*)(F.lds + RING_OFF + F.wave * 8704);
    const int gw = F.vcu * NWAVES + F.wave, NGW = F.G * NWAVES, lane = F.lane;
    constexpr int NITEMS = 16 * 160 + 8 * 32 + 8 * 32 + 16 * 32 + 16 * 64;
    const int it1 = gw + NGW, it2 = gw + 2 * NGW;
    const P0Item d0 = p0_item(F, gw), d1 = p0_item(F, it1 < NITEMS ? it1 : gw), d2 = p0_item(F, it2 < NITEMS ? it2 : gw);
    float w0[32], w1[32], w2[32];
    p0_item_load(d0, w0, lane);
    if (it1 < NITEMS) p0_item_load(d1, w1, lane);
    if (it2 < NITEMS) p0_item_load(d2, w2, lane);
    p0_item_store(d0, w0, scr, lane);
    if (it1 < NITEMS) p0_item_store(d1, w1, scr, lane);
    if (it2 < NITEMS) p0_item_store(d2, w2, scr, lane);
    for (int it = gw + 3 * NGW; it < NITEMS; it += NGW) { const P0Item d = p0_item(F, it); float w[32]; p0_item_load(d, w, lane); p0_item_store(d, w, scr, lane); }
}
__device__ __forceinline__ void p0_sec_tables(Frame& F) {
    const int gw = F.vcu * NWAVES + F.wave, NGW = F.G * NWAVES, lane = F.lane;
    for (int it = gw; it < 256; it += NGW) p0_cvt_row(F.sk + (size_t)it * 1024, (bf16*)(F.ws + WS_SK) + (size_t)it * 1024, nullptr, lane);
    {
        f32x4 gsc[4];
#pragma unroll
        for (int j = 0; j < 4; ++j) gsc[j] = ((const GAS f32x4*)F.gffn)[lane + 64 * j] * 508.0f;
        for (int it = gw; it < 8192; it += NGW) {
            const bool isu = it < 4096; const int e0 = (isu ? it : it - 4096) * 4;
            const float* src = isu ? F.u : F.v;
            f32x4 v[4][4];
#pragma unroll
            for (int r = 0; r < 4; ++r)
#pragma unroll
                for (int j = 0; j < 4; ++j) v[r][j] = ((const GAS f32x4*)(src + (size_t)(e0 + r) * 1024))[lane + 64 * j];
            unsigned char* dst = F.ws + (isu ? WS_US8 : WS_VS8) + (size_t)e0 * 128 + 4 * (lane & 31);
#pragma unroll
            for (int r = 0; r < 4; ++r)
#pragma unroll
                for (int j = 0; j < 4; ++j) { f32x4 t = v[r][j]; unsigned pk;
                    if (isu) { t = t * gsc[j];
                        const int q0 = min(max((int)__builtin_rintf(t.x), -127), 127), q1 = min(max((int)__builtin_rintf(t.y), -127), 127), q2 = min(max((int)__builtin_rintf(t.z), -127), 127), q3 = min(max((int)__builtin_rintf(t.w), -127), 127);
                        pk = (unsigned)(q0 & 255) | ((unsigned)(q1 & 255) << 8) | ((unsigned)(q2 & 255) << 16) | ((unsigned)q3 << 24); }
                    else { t = t * 32.0f; int p = __builtin_amdgcn_cvt_pk_fp8_f32(t.x, t.y, 0, false); p = __builtin_amdgcn_cvt_pk_fp8_f32(t.z, t.w, p, true); pk = (unsigned)p; }
                    *(GAS unsigned*)(dst + (size_t)(2 * j + (lane >> 5)) * 16384 * 128 + r * 128) = pk; }
        }
    }
}
__device__ __forceinline__ void p0_sec_xrows(Frame& F) {
    const int gw = F.vcu * NWAVES + F.wave, NGW = F.G * NWAVES, lane = F.lane;
    {
        float wfr[4][4][8];
#pragma unroll
        for (int q = 0; q < 4; ++q)
#pragma unroll
            for (int e = 0; e < 4; ++e) { const int k = 4 * lane + 256 * q + e; const float g = F.gmix[k]; const GAS f32x4* wp = (const GAS f32x4*)(F.win + (size_t)k * INC + FF_OFF);
                const f32x4 a = wp[0], b = wp[1]; wfr[q][e][0] = a.x * g; wfr[q][e][1] = a.y * g; wfr[q][e][2] = a.z * g; wfr[q][e][3] = a.w * g; wfr[q][e][4] = b.x * g; wfr[q][e][5] = b.y * g; wfr[q][e][6] = b.z * g; wfr[q][e][7] = b.w * g; }
        const float bfl = F.bforget[lane & 7];
        const int xw0 = (F.vcu >= 33 && F.G > 64) ? (F.vcu - 33) * NWAVES + F.wave : (F.G > 64 ? MROWS : gw), XNW = F.G > 64 ? (F.G - 33) * NWAVES : NGW;
        f32x4 vn[4], vn2[4];
#pragma unroll
        for (int q = 0; q < 4; ++q) { vn[q] = ((const GAS f32x4*)(F.x + (size_t)(xw0 < MROWS ? xw0 : 0) * 1024) + lane)[64 * q]; vn2[q] = ((const GAS f32x4*)(F.x + (size_t)(xw0 + XNW < MROWS ? xw0 + XNW : 0) * 1024) + lane)[64 * q]; }
        for (int m = xw0; m < MROWS; m += XNW) {
            f32x4 v[4]; float ss = 0.f;
#pragma unroll
            for (int q = 0; q < 4; ++q) { v[q] = vn[q]; vn[q] = vn2[q]; ss += (v[q].x * v[q].x + v[q].y * v[q].y) + (v[q].z * v[q].z + v[q].w * v[q].w); }
            { const int mn = (m + 2 * XNW < MROWS) ? m + 2 * XNW : m; const GAS f32x4* xn = (const GAS f32x4*)(F.x + (size_t)mn * 1024) + lane;
#pragma unroll
              for (int q = 0; q < 4; ++q) vn2[q] = xn[64 * q]; }
            const float rs = 1.0f / sqrtf(wave_sum(ss) * (1.0f / 1024.0f) + 1e-6f);
            GAS unsigned* o8 = (GAS unsigned*)(F.ws + WS_XB + (size_t)m * 1024) + lane;
            float fl[8];
#pragma unroll
            for (int h = 0; h < 8; ++h) fl[h] = 0.f;
#pragma unroll
            for (int q = 0; q < 4; ++q) { const float r16 = rs * SC_X; o8[64 * q] = pg8::cvt_pk4_fp8(v[q].x * r16, v[q].y * r16, v[q].z * r16, v[q].w * r16);
#pragma unroll
                for (int h = 0; h < 8; ++h) fl[h] += (v[q].x * wfr[q][0][h] + v[q].y * wfr[q][1][h]) + (v[q].z * wfr[q][2][h] + v[q].w * wfr[q][3][h]); }
            float mine = 0.f;
#pragma unroll
            for (int h = 0; h < 8; ++h) { const float t = wave_sum(fl[h]); if ((lane & 7) == h) mine = t; }
            if (lane < 8) ((GAS float*)(F.ws + WS_LOGF))[(size_t)m * 8 + lane] = log_sigmoid(mine * rs + bfl);
        }
    }
}
__device__ __forceinline__ void p0_prologue(Frame& F) {
    if (F.vcu < 33) p0_meta(F, F.vcu);
    if (F.vcu == 33 && F.tid < 256) { const int t = F.tid, w = t >> 6, d = t & 63; float gv; if (w == 0) gv = F.dqg[d]; else if (w == 1) gv = F.dkg[d]; else if (w == 2) gv = F.fqg[d]; else gv = F.fkg[d]; ((GAS float*)(F.ws + WS_GAINS))[t] = gv; }
    if (F.wave & 1) { p0_sec_xrows(F); p0_sec_tables(F); p0_sec_transposes(F); }
    else { p0_sec_transposes(F); p0_sec_tables(F); p0_sec_xrows(F); }
    __syncthreads();
}

__device__ __forceinline__ void p1_cumscan(Frame& F, int bh) {
    LAS float* part = (LAS float*)F.lds;
    const int b = bh >> 3, h = bh & 7, lane = mk_lane(), wave = F.wave, tid = wave * 64 + lane;
    const GAS float* lf = (const GAS float*)(F.ws + WS_LOGF) + (size_t)b * SEQ * 8 + h;
    const GAS float* lfm = (const GAS float*)(F.ws + WS_LOGFM) + h;
    GAS float* cb = (GAS float*)(F.ws + WS_CB) + (size_t)bh * KROWS;
    float cm = 0.f; float lm[16];
#pragma unroll
    for (int m = 0; m < 16; ++m) lm[m] = lfm[m * 8];
#pragma unroll
    for (int m = 0; m < 16; ++m) { cm += lm[m]; if (tid == m) cb[2048 + m] = -cm * LOG2E; }
    if (tid >= 16 && tid < 64) cb[2048 + tid] = 0.f;
    float l0 = lf[(size_t)(4 * tid + 0) * 8], l1 = lf[(size_t)(4 * tid + 1) * 8], l2 = lf[(size_t)(4 * tid + 2) * 8], l3 = lf[(size_t)(4 * tid + 3) * 8];
    l1 += l0; l2 += l1; l3 += l2;
    float incl = l3;
#pragma unroll
    for (int o = 1; o < 64; o <<= 1) { const float t = __shfl_up(incl, o); if (lane >= o) incl += t; }
    if (lane == 63) part[wave] = incl;
    __syncthreads();
    float base = cm;
    for (int w = 0; w < wave; ++w) base += part[w];
    base += incl - l3;
    cb[4 * tid + 0] = -(base + l0) * LOG2E; cb[4 * tid + 1] = -(base + l1) * LOG2E; cb[4 * tid + 2] = -(base + l2) * LOG2E; cb[4 * tid + 3] = -(base + l3) * LOG2E;
    __syncthreads();
}

__device__ __forceinline__ void p2b_combine(Frame& F) {
    const int gw = F.vcu * NWAVES + F.wave, NGW = F.G * NWAVES, lane = mk_lane();
    float s01 = 0.f, s23 = 0.f;
    { const float a = F.dlam[lane], b = F.dlam[64 + lane], c = F.dlam[128 + lane], d = F.dlam[192 + lane]; s01 = wave_sum(a * b); s23 = wave_sum(c * d); }
    const float lam = expf(s01) - expf(s23) + 0.2f;
    const int h = lane >> 4, dch = (lane & 15) * 8;
    float g8[8];
#pragma unroll
    for (int e = 0; e < 8; ++e) g8[e] = F.dsg[dch + e] * 0.8f;
    const bf16* OD = (const bf16*)(F.ws + WS_OD); bf16* YA = (bf16*)(F.ws + WS_YA);
    for (int m = gw; m < MROWS; m += NGW) {
        const v4u a = *(const GAS v4u*)(OD + (size_t)m * 1024 + h * 128 + dch), b = *(const GAS v4u*)(OD + (size_t)m * 1024 + (4 + h) * 128 + dch);
        float od[8] = {pg8::bf_lo(a.x) - lam * pg8::bf_lo(b.x), pg8::bf_hi(a.x) - lam * pg8::bf_hi(b.x), pg8::bf_lo(a.y) - lam * pg8::bf_lo(b.y), pg8::bf_hi(a.y) - lam * pg8::bf_hi(b.y),
                       pg8::bf_lo(a.z) - lam * pg8::bf_lo(b.z), pg8::bf_hi(a.z) - lam * pg8::bf_hi(b.z), pg8::bf_lo(a.w) - lam * pg8::bf_lo(b.w), pg8::bf_hi(a.w) - lam * pg8::bf_hi(b.w)};
        float ss = 0.f;
#pragma unroll
        for (int e = 0; e < 8; ++e) ss += od[e] * od[e];
        ss += __shfl_xor(ss, 1); ss += __shfl_xor(ss, 2); ss += __shfl_xor(ss, 4); ss += __shfl_xor(ss, 8);
        const float rs = 1.0f / sqrtf(ss * (1.0f / 128.0f) + 1e-6f);
        v4u w; w.x = pk2(od[0] * rs * g8[0], od[1] * rs * g8[1]); w.y = pk2(od[2] * rs * g8[2], od[3] * rs * g8[3]); w.z = pk2(od[4] * rs * g8[4], od[5] * rs * g8[5]); w.w = pk2(od[6] * rs * g8[6], od[7] * rs * g8[7]);
        *(GAS v4u*)(YA + (size_t)m * 512 + h * 128 + dch) = w;
    }
}

__device__ __forceinline__ void p2_attention(Frame& F, char* lds) {
    using abf = attn_body::bf16;
    const int v = F.vcu;
    float lam;
    { const int lane = mk_lane(); const float a = F.dlam[lane], b = F.dlam[64 + lane], c = F.dlam[128 + lane], d = F.dlam[192 + lane];
      lam = __uint_as_float(__builtin_amdgcn_readfirstlane(__float_as_uint(expf(wave_sum(a * b)) - expf(wave_sum(c * d)) + 0.2f))); }
    for (int i = 0; i < 4; ++i) {
        const int s = v & 3, qb = (i & 2) ? 7 - s : s, g = i & 1;
        const int b = v >> 4, h = (v >> 2) & 3;
        const abf* Qb = (const abf*)(F.ws + WS_DQ) + ((size_t)b * SEQ + 256 * qb) * 512 + (g * 4 + h) * 64;
        const abf* Kb = (const abf*)(F.ws + WS_DK) + ((size_t)b * KROWS) * 512 + (g * 4 + h) * 64;
        const abf* Vb = (const abf*)(F.ws + WS_DV) + ((size_t)b * KROWS) * 512 + h * 128;
        abf* Ob = (abf*)(F.ws + WS_OD) + ((size_t)b * SEQ + 256 * qb) * 1024 + (g * 4 + h) * 128;
        attn_body::attn_unit_dv2<40, false, false>(F.wave, qb, Qb, Kb, Vb, Ob, 1024, nullptr, lds);
        if (i & 1) {
            asm volatile("s_waitcnt vmcnt(0)" ::: "memory");
            const int lane = mk_lane_v(), r = lane >> 1, hf = lane & 1;
            const size_t row = (size_t)b * SEQ + 256 * qb + 32 * F.wave + r;
            const bf16* o0 = (const bf16*)(F.ws + WS_OD) + row * 1024 + h * 128 + hf * 64;
            const bf16* o1 = o0 + 512;
            v4u a[8], c[8];
#pragma unroll
            for (int q = 0; q < 8; ++q) { a[q] = *(const GAS v4u*)(o0 + 8 * q); c[q] = *(const GAS v4u*)(o1 + 8 * q); }
            float ss = 0.f; float od[64];
#pragma unroll
            for (int q = 0; q < 8; ++q) {
                od[8 * q + 0] = pg8::bf_lo(a[q].x) - lam * pg8::bf_lo(c[q].x); od[8 * q + 1] = pg8::bf_hi(a[q].x) - lam * pg8::bf_hi(c[q].x);
                od[8 * q + 2] = pg8::bf_lo(a[q].y) - lam * pg8::bf_lo(c[q].y); od[8 * q + 3] = pg8::bf_hi(a[q].y) - lam * pg8::bf_hi(c[q].y);
                od[8 * q + 4] = pg8::bf_lo(a[q].z) - lam * pg8::bf_lo(c[q].z); od[8 * q + 5] = pg8::bf_hi(a[q].z) - lam * pg8::bf_hi(c[q].z);
                od[8 * q + 6] = pg8::bf_lo(a[q].w) - lam * pg8::bf_lo(c[q].w); od[8 * q + 7] = pg8::bf_hi(a[q].w) - lam * pg8::bf_hi(c[q].w);
#pragma unroll
                for (int e = 0; e < 8; ++e) ss += od[8 * q + e] * od[8 * q + e];
            }
            ss += dppx<0xB1>(ss);
            const float rs = __builtin_amdgcn_rsqf(ss * (1.0f / 128.0f) + 1e-6f) * 0.8f;
            unsigned char* yo = F.ws + WS_YA + row * 512 + h * 128 + hf * 64;
            const float rsa = rs * SC_A;
#pragma unroll
            for (int q = 0; q < 4; ++q) { const GAS f32x4* gp = (const GAS f32x4*)(F.dsg + hf * 64 + 16 * q); const f32x4 g0 = gp[0], g1 = gp[1], g2 = gp[2], g3 = gp[3];
                v4u w; w.x = pg8::cvt_pk4_fp8(od[16 * q] * rsa * g0.x, od[16 * q + 1] * rsa * g0.y, od[16 * q + 2] * rsa * g0.z, od[16 * q + 3] * rsa * g0.w);
                w.y = pg8::cvt_pk4_fp8(od[16 * q + 4] * rsa * g1.x, od[16 * q + 5] * rsa * g1.y, od[16 * q + 6] * rsa * g1.z, od[16 * q + 7] * rsa * g1.w);
                w.z = pg8::cvt_pk4_fp8(od[16 * q + 8] * rsa * g2.x, od[16 * q + 9] * rsa * g2.y, od[16 * q + 10] * rsa * g2.z, od[16 * q + 11] * rsa * g2.w);
                w.w = pg8::cvt_pk4_fp8(od[16 * q + 12] * rsa * g3.x, od[16 * q + 13] * rsa * g3.y, od[16 * q + 14] * rsa * g3.z, od[16 * q + 15] * rsa * g3.w);
                *(GAS v4u*)(yo + 16 * q) = w; }
        }
    }
    asm volatile("" ::: "memory");
    for (int i = 0; i < 4; ++i) {
        const int fp = 2 * v + (i >> 1), fg = fp >> 2, s = fp & 3, qb = (i & 1) ? 7 - s : s;
        const int b = fg >> 3, h = fg & 7;
        const abf* Qb = (const abf*)(F.ws + WS_FQ) + ((size_t)b * SEQ + 256 * qb) * 512 + h * 64;
        const abf* Kb = (const abf*)(F.ws + WS_FK) + ((size_t)b * KROWS) * 512 + h * 64;
        const abf* Vb = (const abf*)(F.ws + WS_FV) + ((size_t)b * KROWS) * 512 + h * 64;
        abf* Ob = (abf*)(F.ws + WS_OF + ((size_t)b * SEQ + 256 * qb) * 512 + h * 64);
        const float* cbv = (const float*)(F.ws + WS_CB) + (size_t)(b * 8 + h) * KROWS;
        attn_body::attn_unit<40, true>(F.wave, qb, Qb, Kb, Vb, Ob, 512, cbv, lds);
    }
}

typedef float f32x16p __attribute__((ext_vector_type(16)));
typedef __bf16 bf16x2p __attribute__((ext_vector_type(2)));
constexpr int SKROW = 272;
__device__ __forceinline__ unsigned f2key(float f) { return __float_as_uint(f); }
__device__ __forceinline__ float key2f(unsigned k) { return __uint_as_float(k); }
#define CEU(a, b) do { const float _a = __uint_as_float(a), _b = __uint_as_float(b); (a) = __float_as_uint(__builtin_amdgcn_fmed3f(_a, _b, __builtin_inff())); (b) = __float_as_uint(__builtin_amdgcn_fmed3f(_a, _b, -__builtin_inff())); } while (0)
__device__ __forceinline__ void sort16_desc(unsigned (&v)[16]) {
    CEU(v[0], v[13]); CEU(v[1], v[12]); CEU(v[2], v[15]); CEU(v[3], v[14]); CEU(v[4], v[8]); CEU(v[5], v[6]); CEU(v[7], v[11]); CEU(v[9], v[10]);
    CEU(v[0], v[5]); CEU(v[1], v[7]); CEU(v[2], v[9]); CEU(v[3], v[4]); CEU(v[6], v[13]); CEU(v[8], v[14]); CEU(v[10], v[15]); CEU(v[11], v[12]);
    CEU(v[0], v[1]); CEU(v[2], v[3]); CEU(v[4], v[5]); CEU(v[6], v[8]); CEU(v[7], v[9]); CEU(v[10], v[11]); CEU(v[12], v[13]); CEU(v[14], v[15]);
    CEU(v[0], v[2]); CEU(v[1], v[3]); CEU(v[4], v[10]); CEU(v[5], v[11]); CEU(v[6], v[7]); CEU(v[8], v[9]); CEU(v[12], v[14]); CEU(v[13], v[15]);
    CEU(v[1], v[2]); CEU(v[3], v[12]); CEU(v[4], v[6]); CEU(v[5], v[7]); CEU(v[8], v[10]); CEU(v[9], v[11]); CEU(v[13], v[14]);
    CEU(v[1], v[4]); CEU(v[2], v[6]); CEU(v[5], v[8]); CEU(v[7], v[10]); CEU(v[9], v[13]); CEU(v[11], v[14]);
    CEU(v[2], v[4]); CEU(v[3], v[6]); CEU(v[9], v[12]); CEU(v[11], v[13]);
    CEU(v[3], v[5]); CEU(v[6], v[8]); CEU(v[7], v[9]); CEU(v[10], v[12]);
    CEU(v[3], v[4]); CEU(v[5], v[6]); CEU(v[7], v[8]); CEU(v[9], v[10]); CEU(v[11], v[12]);
    CEU(v[6], v[7]); CEU(v[8], v[9]);
}
__device__ __forceinline__ void merge16_desc(unsigned (&R)[16], const unsigned (&C)[16]) {
#pragma unroll
    for (int i = 0; i < 16; ++i) R[i] = __float_as_uint(__builtin_amdgcn_fmed3f(__uint_as_float(R[i]), __uint_as_float(C[15 - i]), __builtin_inff()));
#pragma unroll
    for (int j = 8; j > 0; j >>= 1)
#pragma unroll
        for (int i = 0; i < 16; ++i) { const int l = i ^ j; if (l > i) CEU(R[i], R[l]); }
}
__device__ __forceinline__ unsigned sel4(unsigned w0, unsigned w1, unsigned w2, unsigned w3, int i) { unsigned r = w0; r = i == 1 ? w1 : r; r = i == 2 ? w2 : r; r = i == 3 ? w3 : r; return r; }

__device__ __forceinline__ void p6_topk(Frame& F) {
    int tid_ = F.wave * 64 + mk_lane(); asm volatile("" : "+v"(tid_));
    const int tid = tid_, lane = tid & 63, wave = F.wave, r32 = lane & 31, hi = lane >> 5;
    const int h = F.vcu & 7, wgh = F.vcu >> 3;
    LAS unsigned char* skl = F.lds;
    { const bf16* SK = (const bf16*)(F.ws + WS_SK) + (size_t)h * 256 * 128;
      for (int idx = tid; idx < 4096; idx += 512) { const int ck = idx >> 4, ch = idx & 15; const v4u val = *(const GAS v4u*)(SK + (size_t)ck * 128 + ch * 8); *(LAS v4u*)(skl + ck * SKROW + ch * 16) = val; } }
    __syncthreads();
    const bf16* Q2 = (const bf16*)(F.ws + WS_Q2);
    bf16x8 qf[2][8];
#define P6_LOADQ(TT) do { const int tk_ = (wgh * 4 + (TT)) * 256 + wave * 32 + r32; _Pragma("unroll") for (int c = 0; c < 2; ++c) _Pragma("unroll") for (int ks = 0; ks < 8; ++ks) \
        qf[c][ks] = *(const GAS bf16x8*)(Q2 + (size_t)tk_ * 2048 + h * 256 + c * 128 + ks * 16 + hi * 8); } while (0)
    P6_LOADQ(0);
    for (int tt = 0; tt < 4; ++tt) {
        const int tok = (wgh * 4 + tt) * 256 + wave * 32 + r32;
        unsigned R[16];
#pragma unroll
        for (int r = 0; r < 16; ++r) R[r] = 0xff800000u;
#pragma nounroll
        for (int kt = 0; kt < 4; ++kt) {
            f32x16p a0 = {}, a1 = {};
#pragma unroll
            for (int ks = 0; ks < 8; ++ks) {
                const bf16x8 s0 = *(const LAS bf16x8*)(skl + (0 * 128 + kt * 32 + r32) * SKROW + ks * 32 + hi * 16);
                const bf16x8 s1 = *(const LAS bf16x8*)(skl + (1 * 128 + kt * 32 + r32) * SKROW + ks * 32 + hi * 16);
                a0 = __builtin_amdgcn_mfma_f32_32x32x16_bf16(s0, qf[0][ks], a0, 0, 0, 0);
                a1 = __builtin_amdgcn_mfma_f32_32x32x16_bf16(s1, qf[1][ks], a1, 0, 0, 0);
            }
            unsigned X[16], Y[16];
#pragma unroll
            for (int r = 0; r < 16; ++r) {
                const auto rr = __builtin_amdgcn_permlane32_swap(__float_as_uint(a0[r]), __float_as_uint(a1[r]), false, false);
                const unsigned kidx = (unsigned)(kt * 32 + (r & 3) + 8 * (r >> 2));
                X[r] = (f2key(__uint_as_float(rr[0])) & ~0x7fu) | kidx;
                Y[r] = (f2key(__uint_as_float(rr[1])) & ~0x7fu) | (kidx + 4u);
            }
            sort16_desc(X); sort16_desc(Y);
            merge16_desc(R, X);
            merge16_desc(R, Y);
        }
        if (tt < 3) P6_LOADQ(tt + 1);
        unsigned A[16], B[16];
#pragma unroll
        for (int r = 0; r < 16; ++r) { const auto rr = __builtin_amdgcn_permlane32_swap(R[r], R[r], false, false); A[r] = rr[0]; B[r] = rr[1]; }
        float s1[16], s2[16];
#pragma unroll
        for (int r = 0; r < 16; ++r) { s1[r] = key2f(A[r] & ~0x7fu); s2[r] = key2f(B[r] & ~0x7fu); }
#define PK4(V, q) ((V[4 * q] & 0x7fu) | ((V[4 * q + 1] & 0x7fu) << 8) | ((V[4 * q + 2] & 0x7fu) << 16) | ((V[4 * q + 3] & 0x7fu) << 24))
        const unsigned i1a = PK4(A, 0), i1b = PK4(A, 1), i1c = PK4(A, 2), i1d = PK4(A, 3), i2a = PK4(B, 0), i2b = PK4(B, 1), i2c = PK4(B, 2), i2d = PK4(B, 3);
#undef PK4
#define PKEY(a, b) ((f2key(s1[a] + s2[b]) & ~0xffu) | (unsigned)((a) * 16 + (b)))
        unsigned L[16], C1[16], C2[16], C3[16];
#pragma unroll
        for (int b = 0; b < 16; ++b) L[b] = PKEY(0, b);
#pragma unroll
        for (int b = 0; b < 8; ++b) { C1[b] = PKEY(1, b); C1[8 + b] = PKEY(8 + b, 0); }
#pragma unroll
        for (int b = 0; b < 5; ++b) C2[b] = PKEY(2, b);
#pragma unroll
        for (int b = 0; b < 4; ++b) C2[5 + b] = PKEY(3, b);
#pragma unroll
        for (int b = 0; b < 3; ++b) C2[9 + b] = PKEY(4, b);
        C2[12] = PKEY(5, 0); C2[13] = PKEY(5, 1); C2[14] = PKEY(6, 0); C2[15] = PKEY(6, 1);
        C3[0] = PKEY(7, 0); C3[1] = PKEY(7, 1);
#pragma unroll
        for (int b = 2; b < 16; ++b) C3[b] = 0xff800000u;
#undef PKEY
        sort16_desc(C1); sort16_desc(C2);
        merge16_desc(L, C1); merge16_desc(L, C2); merge16_desc(L, C3);
        float val[16]; unsigned eid[16];
#pragma unroll
        for (int k = 0; k < 16; ++k) { const unsigned key = L[k]; const int a = (key >> 4) & 15, b = key & 15; val[k] = key2f(key & ~0xffu);
            const unsigned ia = (sel4(i1a, i1b, i1c, i1d, a >> 2) >> (8 * (a & 3))) & 0x7fu, ib = (sel4(i2a, i2b, i2c, i2d, b >> 2) >> (8 * (b & 3))) & 0x7fu; eid[k] = ia * 128u + ib; }
        float sum = 0.f; const float vmax = val[0];
        float rsl;
        { const GAS f32x4* sp = (const GAS f32x4*)((const float*)(F.ws + WS_SSQP) + (size_t)tok * 16); const f32x4 s0 = sp[0], s1q = sp[1], s2q = sp[2], s3 = sp[3];
          const float tot = ((s0[0] + s0[1]) + (s0[2] + s0[3])) + ((s1q[0] + s1q[1]) + (s1q[2] + s1q[3])) + ((s2q[0] + s2q[1]) + (s2q[2] + s2q[3])) + ((s3[0] + s3[1]) + (s3[2] + s3[3]));
          rsl = __builtin_amdgcn_rsqf(tot * (1.0f / 1024.0f) + 1e-6f) * LOG2E; }
#pragma unroll
        for (int k = 0; k < 16; ++k) { val[k] = __builtin_amdgcn_exp2f((val[k] - vmax) * rsl); sum += val[k]; }
        const float inv = 1.0f / sum;
        if (hi == 0) {
            GAS v4u* ep = (GAS v4u*)((unsigned short*)(F.ws + WS_EIDX) + (size_t)tok * 128 + h * 16);
            ep[0] = (v4u){eid[0] | (eid[1] << 16), eid[2] | (eid[3] << 16), eid[4] | (eid[5] << 16), eid[6] | (eid[7] << 16)};
            ep[1] = (v4u){eid[8] | (eid[9] << 16), eid[10] | (eid[11] << 16), eid[12] | (eid[13] << 16), eid[14] | (eid[15] << 16)};
            GAS f32x4* gp = (GAS f32x4*)((float*)(F.ws + WS_GATE) + (size_t)tok * 128 + h * 16);
#pragma unroll
            for (int q = 0; q < 4; ++q) gp[q] = (f32x4){val[4 * q] * inv, val[4 * q + 1] * inv, val[4 * q + 2] * inv, val[4 * q + 3] * inv};
        }
    }
#undef P6_LOADQ
    __syncthreads();
}

__device__ __forceinline__ float gelu_erf(float v) {
    const float av = fabsf(v), t = __builtin_amdgcn_rcpf(1.0f + 0.2316418882f * av);
    float q = t * 0.5307027145f + (-0.7265760135f); q = q * t + 0.7107068705f; q = q * t + (-0.142248368f); q = q * t + 0.127414796f; q = q * t;
    const float e = __builtin_amdgcn_exp2f((v * v) * (-0.72134752044f));
    const float m = v * (q * e);
    return v < 0.f ? m : v - m;
}
__device__ __forceinline__ float dot2bf(unsigned a, unsigned b, float acc) { return __builtin_amdgcn_fdot2_f32_bf16(__builtin_bit_cast(bf16x2p, a), __builtin_bit_cast(bf16x2p, b), acc, false); }
__device__ __forceinline__ float dot8(const v4u a, const v4u b, float acc) {
    const unsigned a0 = a.x, a1 = a.y, a2 = a.z, a3 = a.w, b0 = b.x, b1 = b.y, b2 = b.z, b3 = b.w;
    acc = dot2bf(a0, b0, acc); acc = dot2bf(a1, b1, acc); acc = dot2bf(a2, b2, acc); acc = dot2bf(a3, b3, acc);
    return acc;
}
typedef float f32x2p __attribute__((ext_vector_type(2)));
constexpr float U_SCALE = 256.0f, V_SCALE = 32.0f;
__device__ __forceinline__ void fp8x16_to_f32(const v4u r, float (&f)[16]) {
    const unsigned w0 = r.x, w1 = r.y, w2 = r.z, w3 = r.w;
    f32x2p a;
    a = __builtin_amdgcn_cvt_pk_f32_fp8((int)w0, false); f[0] = a.x; f[1] = a.y; a = __builtin_amdgcn_cvt_pk_f32_fp8((int)w0, true); f[2] = a.x; f[3] = a.y;
    a = __builtin_amdgcn_cvt_pk_f32_fp8((int)w1, false); f[4] = a.x; f[5] = a.y; a = __builtin_amdgcn_cvt_pk_f32_fp8((int)w1, true); f[6] = a.x; f[7] = a.y;
    a = __builtin_amdgcn_cvt_pk_f32_fp8((int)w2, false); f[8] = a.x; f[9] = a.y; a = __builtin_amdgcn_cvt_pk_f32_fp8((int)w2, true); f[10] = a.x; f[11] = a.y;
    a = __builtin_amdgcn_cvt_pk_f32_fp8((int)w3, false); f[12] = a.x; f[13] = a.y; a = __builtin_amdgcn_cvt_pk_f32_fp8((int)w3, true); f[14] = a.x; f[15] = a.y;
}
template <int CTRL> __device__ __forceinline__ float dppf(float x) { return __builtin_amdgcn_update_dpp(0.f, x, CTRL, 0xf, 0xf, true); }
__device__ __forceinline__ float oct_sum(float v) { v += dppf<0xB1>(v); v += dppf<0x4E>(v); v += dppf<0x141>(v); return v; }

struct UIn { v4u id0, id1, x0, x1; };
__device__ __forceinline__ UIn p7a_in(const unsigned char* EIb, const unsigned char* Hb, unsigned t, unsigned oct, unsigned xoff) {
    UIn r; const unsigned eo = t * 256u + 32u * oct, xo = t * 2048u + xoff;
    r.id0 = *(const GAS v4u*)(EIb + eo); r.id1 = *(const GAS v4u*)(EIb + (eo + 16u));
    r.x0 = *(const GAS v4u*)(Hb + xo); r.x1 = *(const GAS v4u*)(Hb + (xo + 16u)); return r;
}
__device__ __forceinline__ void p7_rows8(const unsigned char* TB, unsigned lo, const v4u id, v4u (&rows)[8]) {
    const unsigned ix = id.x, iy = id.y, iz = id.z, iw = id.w;
    rows[0] = *(const GAS v4u*)(TB + ((ix & 0xffffu) * 128u + lo)); rows[1] = *(const GAS v4u*)(TB + ((ix >> 16) * 128u + lo));
    rows[2] = *(const GAS v4u*)(TB + ((iy & 0xffffu) * 128u + lo)); rows[3] = *(const GAS v4u*)(TB + ((iy >> 16) * 128u + lo));
    rows[4] = *(const GAS v4u*)(TB + ((iz & 0xffffu) * 128u + lo)); rows[5] = *(const GAS v4u*)(TB + ((iz >> 16) * 128u + lo));
    rows[6] = *(const GAS v4u*)(TB + ((iw & 0xffffu) * 128u + lo)); rows[7] = *(const GAS v4u*)(TB + ((iw >> 16) * 128u + lo));
}
typedef _Float16 h2p __attribute__((ext_vector_type(2)));
#define CVH(w, s, sel) __builtin_bit_cast(h2p, __builtin_amdgcn_cvt_scalef32_pk_f16_fp8(w, s, sel))
__device__ __forceinline__ h2p bf2_to_h2(unsigned w) { const f32x2p f = {pg8::bf_lo(w), pg8::bf_hi(w)}; return __builtin_convertvector(f, h2p); }
constexpr float U8_SCALE = 508.0f;
template <int CTRL> __device__ __forceinline__ int dppi(int x) { return __builtin_amdgcn_update_dpp(0, x, CTRL, 0xf, 0xf, true); }
__device__ __forceinline__ int oct_sum_i(int v) { v += dppi<0xB1>(v); v += dppi<0x4E>(v); v += dppi<0x141>(v); return v; }
__device__ __forceinline__ float oct_max(float v) { v = fmaxf(v, dppf<0xB1>(v)); v = fmaxf(v, dppf<0x4E>(v)); v = fmaxf(v, dppf<0x141>(v)); return v; }
__device__ __forceinline__ unsigned pack4_i8(float a, float b, float c, float d, float qs) {
    const int q0 = (int)__builtin_rintf(a * qs), q1 = (int)__builtin_rintf(b * qs), q2 = (int)__builtin_rintf(c * qs), q3 = (int)__builtin_rintf(d * qs);
    return (unsigned)(q0 & 255) | ((unsigned)(q1 & 255) << 8) | ((unsigned)(q2 & 255) << 16) | ((unsigned)q3 << 24);
}
__device__ __forceinline__ void p7a_half(const v4u (&rows)[8], const unsigned (&xq)[4], float dq, float (&p)[8]) {
#pragma unroll
    for (int j = 0; j < 8; ++j) { const unsigned w0 = rows[j].x, w1 = rows[j].y, w2 = rows[j].z, w3 = rows[j].w;
        int a = __builtin_amdgcn_sdot4((int)w0, (int)xq[0], 0, false); a = __builtin_amdgcn_sdot4((int)w1, (int)xq[1], a, false);
        a = __builtin_amdgcn_sdot4((int)w2, (int)xq[2], a, false); a = __builtin_amdgcn_sdot4((int)w3, (int)xq[3], a, false);
        p[j] = (float)oct_sum_i(a) * dq;
        if (j & 1) __builtin_amdgcn_sched_barrier(0); }
}
__device__ __forceinline__ void p7a_udot(Frame& F) {
    int lane_ = mk_lane(); asm volatile("" : "+v"(lane_));
    const int lane = lane_, wave = F.wave, oct = lane >> 3, li8 = lane & 7;
    const int nloc = (int)F.MISC[8], nx = (int)F.MISC[9], rank = (int)F.MISC[10], xidx = (int)F.MISC[11];
    for (int sl = xidx; sl < 8; sl += nx) {
    const unsigned char* US = F.ws + WS_US8 + (size_t)sl * 16384 * 128; const unsigned lo = (unsigned)li8 * 16u;
    _Float16* PD = (_Float16*)(F.ws + WS_PD) + (size_t)sl * MROWS * 128;
    const unsigned char* H1B = F.ws + WS_H1B;
    const unsigned short* EI = (const unsigned short*)(F.ws + WS_EIDX);
    int tb_ = __builtin_amdgcn_readfirstlane(rank * 8 + wave); asm volatile("" : "+s"(tb_));
    const int tb = tb_, tstep = nloc * 8, nit = (MROWS - tb + tstep - 1) / tstep;
#define TOK(i) min(tb + tstep * (i), MROWS - 1)
    const unsigned char* EIb = (const unsigned char*)EI; const unsigned char* Hb = (const unsigned char*)H1B; const unsigned xoff = (unsigned)(128 * sl + 16 * li8) * 2u;
    UIn cur = p7a_in(EIb, Hb, (unsigned)TOK(0), (unsigned)oct, xoff);
    v4u rowsA[8], rowsB[8];
    p7_rows8(US, lo, cur.id0, rowsA);
    for (int i = 0; i < nit; ++i) {
        p7_rows8(US, lo, cur.id1, rowsB);
        const UIn nxt = p7a_in(EIb, Hb, (unsigned)TOK(i + 1), (unsigned)oct, xoff);
        const unsigned xw[8] = {cur.x0.x, cur.x0.y, cur.x0.z, cur.x0.w, cur.x1.x, cur.x1.y, cur.x1.z, cur.x1.w};
        float xf[16]; float am = 0.f;
#pragma unroll
        for (int q = 0; q < 8; ++q) { xf[2 * q] = pg8::bf_lo(xw[q]); xf[2 * q + 1] = pg8::bf_hi(xw[q]); am = fmaxf(am, fmaxf(fabsf(xf[2 * q]), fabsf(xf[2 * q + 1]))); }
        am = fmaxf(oct_max(am), 1e-20f);
        const float qs = 127.0f * __builtin_amdgcn_rcpf(am), dq = am * (1.0f / (127.0f * U8_SCALE));
        const unsigned xs[4] = {pack4_i8(xf[0], xf[1], xf[2], xf[3], qs), pack4_i8(xf[4], xf[5], xf[6], xf[7], qs), pack4_i8(xf[8], xf[9], xf[10], xf[11], qs), pack4_i8(xf[12], xf[13], xf[14], xf[15], qs)};
        float pa[8], pb[8];
        __builtin_amdgcn_sched_barrier(0);
        p7a_half(rowsA, xs, dq, pa);
        __builtin_amdgcn_sched_barrier(0);
        p7_rows8(US, lo, nxt.id0, rowsA);
        __builtin_amdgcn_sched_barrier(0);
        p7a_half(rowsB, xs, dq, pb);
        __builtin_amdgcn_sched_barrier(0);
        if (li8 < 4) {
            f32x4 o;
            o.x = li8 == 0 ? pa[0] : li8 == 1 ? pa[4] : li8 == 2 ? pb[0] : pb[4];
            o.y = li8 == 0 ? pa[1] : li8 == 1 ? pa[5] : li8 == 2 ? pb[1] : pb[5];
            o.z = li8 == 0 ? pa[2] : li8 == 1 ? pa[6] : li8 == 2 ? pb[2] : pb[6];
            o.w = li8 == 0 ? pa[3] : li8 == 1 ? pa[7] : li8 == 2 ? pb[3] : pb[7];
            const f32x2p lo2 = {o.x, o.y}, hi2 = {o.z, o.w};
            v2u w; w.x = __builtin_bit_cast(unsigned, __builtin_convertvector(lo2, h2p)); w.y = __builtin_bit_cast(unsigned, __builtin_convertvector(hi2, h2p));
            *(GAS v2u*)(PD + (size_t)TOK(i) * 128 + 16 * oct + 4 * li8) = w;
        }
        cur = nxt;
    }
    }
}
__device__ __forceinline__ void p7_rows8_eo(const unsigned char* TB, unsigned lo, const v4u ida, const v4u idb, bool odd, v4u (&rows)[8]) {
    const unsigned w[8] = {ida.x, ida.y, ida.z, ida.w, idb.x, idb.y, idb.z, idb.w};
#pragma unroll
    for (int j = 0; j < 8; ++j) rows[j] = *(const GAS v4u*)(TB + ((odd ? (w[j] >> 16) : (w[j] & 0xffffu)) * 128u + lo));
}
template <int CTRL, int BANK> __device__ __forceinline__ int dppi_b(int old, int x) { return __builtin_amdgcn_update_dpp(old, x, CTRL, 0xf, BANK, false); }
__device__ __forceinline__ int oct_transpose_sum(const int (&a)[8], int li8) {
    const bool c0 = li8 & 1, c1 = li8 & 2, c2 = li8 & 4;
    int b[4];
#pragma unroll
    for (int q = 0; q < 4; ++q) { const int keep = c0 ? a[2 * q + 1] : a[2 * q], send = c0 ? a[2 * q] : a[2 * q + 1]; b[q] = keep + dppi<0xB1>(send); }
    int c[2];
#pragma unroll
    for (int q = 0; q < 2; ++q) { const int keep = c1 ? b[2 * q + 1] : b[2 * q], send = c1 ? b[2 * q] : b[2 * q + 1]; c[q] = keep + dppi<0x4E>(send); }
    const int keep = c2 ? c[1] : c[0], send = c2 ? c[0] : c[1];
    int r = dppi_b<0x114, 0xA>(0, send);
    r = dppi_b<0x104, 0x5>(r, send);
    return keep + r;
}
__device__ __forceinline__ int p7a_half_t(const v4u (&rows)[8], const unsigned (&xq)[4], int li8) {
    int a[8];
#pragma unroll
    for (int j = 0; j < 8; ++j) { const unsigned w0 = rows[j].x, w1 = rows[j].y, w2 = rows[j].z, w3 = rows[j].w;
        int s = __builtin_amdgcn_sdot4((int)w0, (int)xq[0], 0, false); s = __builtin_amdgcn_sdot4((int)w1, (int)xq[1], s, false);
        s = __builtin_amdgcn_sdot4((int)w2, (int)xq[2], s, false); a[j] = __builtin_amdgcn_sdot4((int)w3, (int)xq[3], s, false); }
    return oct_transpose_sum(a, li8);
}
__device__ __forceinline__ void p7a_udot2(Frame& F) {
    int lane_ = mk_lane(); asm volatile("" : "+v"(lane_));
    const int lane = lane_, wave = F.wave, oct = lane >> 3, li8 = lane & 7;
    const int nloc = (int)F.MISC[8], nx = (int)F.MISC[9], rank = (int)F.MISC[10], xidx = (int)F.MISC[11];
    for (int sl = xidx; sl < 8; sl += nx) {
    const unsigned char* US = F.ws + WS_US8 + (size_t)sl * 16384 * 128; const unsigned lo = (unsigned)li8 * 16u;
    _Float16* PD = (_Float16*)(F.ws + WS_PD) + (size_t)sl * MROWS * 128;
    const unsigned char* H1B = F.ws + WS_H1B;
    const unsigned short* EI = (const unsigned short*)(F.ws + WS_EIDX);
    int tb_ = __builtin_amdgcn_readfirstlane(rank * 8 + wave); asm volatile("" : "+s"(tb_));
    const int tb = tb_, tstep = nloc * 8, nit = (MROWS - tb + tstep - 1) / tstep;
    const unsigned char* EIb = (const unsigned char*)EI; const unsigned char* Hb = (const unsigned char*)H1B; const unsigned xoff = (unsigned)(128 * sl + 16 * li8) * 2u;
    UIn cur = p7a_in(EIb, Hb, (unsigned)TOK(0), (unsigned)oct, xoff);
    v4u rowsA[8], rowsB[8];
    p7_rows8_eo(US, lo, cur.id0, cur.id1, false, rowsA);
    for (int i = 0; i < nit; ++i) {
        p7_rows8_eo(US, lo, cur.id0, cur.id1, true, rowsB);
        const UIn nxt = p7a_in(EIb, Hb, (unsigned)TOK(i + 1), (unsigned)oct, xoff);
        const unsigned xw[8] = {cur.x0.x, cur.x0.y, cur.x0.z, cur.x0.w, cur.x1.x, cur.x1.y, cur.x1.z, cur.x1.w};
        float xf[16]; float am = 0.f;
#pragma unroll
        for (int q = 0; q < 8; ++q) { xf[2 * q] = pg8::bf_lo(xw[q]); xf[2 * q + 1] = pg8::bf_hi(xw[q]); am = fmaxf(am, fmaxf(fabsf(xf[2 * q]), fabsf(xf[2 * q + 1]))); }
        am = fmaxf(oct_max(am), 1e-20f);
        const float qs = 127.0f * __builtin_amdgcn_rcpf(am), dq = am * (1.0f / (127.0f * U8_SCALE));
        unsigned xs[4];
#pragma unroll
        for (int q = 0; q < 4; ++q) {
            const unsigned m0 = __float_as_uint(__builtin_fmaf(xf[4 * q], qs, 12582912.0f)), m1 = __float_as_uint(__builtin_fmaf(xf[4 * q + 1], qs, 12582912.0f));
            const unsigned m2 = __float_as_uint(__builtin_fmaf(xf[4 * q + 2], qs, 12582912.0f)), m3 = __float_as_uint(__builtin_fmaf(xf[4 * q + 3], qs, 12582912.0f));
            const unsigned lo2 = __builtin_amdgcn_perm(m1, m0, 0x0c0c0400u), hi2 = __builtin_amdgcn_perm(m3, m2, 0x04000c0cu);
            xs[q] = lo2 | hi2;
        }
        __builtin_amdgcn_sched_barrier(0);
        const int ta = p7a_half_t(rowsA, xs, li8);
        __builtin_amdgcn_sched_barrier(0);
        p7_rows8_eo(US, lo, nxt.id0, nxt.id1, false, rowsA);
        __builtin_amdgcn_sched_barrier(0);
        const int tbv = p7a_half_t(rowsB, xs, li8);
        __builtin_amdgcn_sched_barrier(0);
        {
            const f32x2p pr = {(float)ta * dq, (float)tbv * dq};
            *(GAS unsigned*)(PD + (size_t)TOK(i) * 128 + 16 * oct + 2 * li8) = __builtin_bit_cast(unsigned, __builtin_convertvector(pr, h2p));
        }
        cur = nxt;
    }
    }
}
constexpr float W8_SCALE = 16.0f;
__device__ __forceinline__ void w8_pair(float w0, float w1, unsigned short& hi2, unsigned short& lo2) {
    const float a = w0 * W8_SCALE, b = w1 * W8_SCALE;
    const int hp = __builtin_amdgcn_cvt_pk_fp8_f32(a, b, 0, false);
    const float ha = __builtin_amdgcn_cvt_f32_fp8(hp, 0), hb = __builtin_amdgcn_cvt_f32_fp8(hp, 1);
    const int lp = __builtin_amdgcn_cvt_pk_fp8_f32((a - ha) * 16.0f, (b - hb) * 16.0f, 0, false);
    hi2 = (unsigned short)(hp & 0xffff); lo2 = (unsigned short)(lp & 0xffff);
}
__device__ __forceinline__ void p7b_weights(Frame& F) {
    int lane_ = mk_lane(); asm volatile("" : "+v"(lane_));
    const int lane = lane_, gw = F.vcu * NWAVES + F.wave, NGW = F.G * NWAVES;
    const _Float16* PD = (const _Float16*)(F.ws + WS_PD); const float* GT = (const float*)(F.ws + WS_GATE); _Float16* W = (_Float16*)(F.ws + WS_W);
    for (int t0 = gw; t0 < MROWS; t0 += 4 * NGW) {
        unsigned pd[4][8]; f32x2p gt[4]; float sq[4];
#pragma unroll
        for (int j = 0; j < 4; ++j) { const int t = min(t0 + j * NGW, MROWS - 1);
            sq[j] = lane < 16 ? ((const GAS float*)(F.ws + WS_SSQP))[(size_t)t * 16 + lane] : 0.f;
#pragma unroll
            for (int x = 0; x < 8; ++x) pd[j][x] = *(const GAS unsigned*)(PD + ((size_t)x * MROWS + t) * 128 + 2 * lane);
            gt[j] = *(const GAS f32x2p*)(GT + (size_t)t * 128 + 2 * lane); }
#pragma unroll
        for (int j = 0; j < 4; ++j) { const int t = t0 + j * NGW;
            const float rs = __builtin_amdgcn_rsqf(wave_sum(sq[j]) * (1.0f / 1024.0f) + 1e-6f);
            float d0 = 0.f, d1 = 0.f;
#pragma unroll
            for (int x = 0; x < 8; ++x) { const unsigned w_ = pd[j][x]; const h2p hv = __builtin_bit_cast(h2p, w_); d0 += (float)hv.x; d1 += (float)hv.y; }
            const f32x2p wv = {gt[j].x * gelu_erf(d0 * rs), gt[j].y * gelu_erf(d1 * rs)};
            if (t < MROWS) {
                unsigned short hi2, lo2; w8_pair(wv.x, wv.y, hi2, lo2);
                *(GAS unsigned short*)((unsigned char*)W + (size_t)t * 256 + 2 * lane) = hi2; *(GAS unsigned short*)((unsigned char*)W + (size_t)t * 256 + 128 + 2 * lane) = lo2; } }
    }
}
struct VIn { v4u id0, id1, wa, wb; v2u h; };
__device__ __forceinline__ VIn p7c_in(const unsigned char* EIb, const unsigned char* Wb, const unsigned char* hb, unsigned t, unsigned g, unsigned ooff) {
    VIn r; const unsigned eo = t * 256u + 32u * g;
    r.id0 = *(const GAS v4u*)(EIb + eo); r.id1 = *(const GAS v4u*)(EIb + (eo + 16u));
    r.wa = *(const GAS v4u*)(Wb + eo); r.wb = *(const GAS v4u*)(Wb + (eo + 16u));
    r.h = *(const GAS v2u*)(hb + (t * 2048u + (ooff >> 1))); return r;
}
__device__ __forceinline__ float h_lo(unsigned w) { return (float)__builtin_bit_cast(h2p, w).x; }
__device__ __forceinline__ float h_hi(unsigned w) { return (float)__builtin_bit_cast(h2p, w).y; }
#define CVH(w, s, sel) __builtin_bit_cast(h2p, __builtin_amdgcn_cvt_scalef32_pk_f16_fp8(w, s, sel))
__device__ __forceinline__ void p7c_half(const v4u (&rows)[8], const v4u wq, h2p (&acc)[8]) {
    const unsigned q0 = wq.x, q1 = wq.y, q2 = wq.z, q3 = wq.w;
    const h2p w01 = __builtin_bit_cast(h2p, q0), w23 = __builtin_bit_cast(h2p, q1), w45 = __builtin_bit_cast(h2p, q2), w67 = __builtin_bit_cast(h2p, q3);
    const h2p wv[8] = {{w01.x, w01.x}, {w01.y, w01.y}, {w23.x, w23.x}, {w23.y, w23.y}, {w45.x, w45.x}, {w45.y, w45.y}, {w67.x, w67.x}, {w67.y, w67.y}};
#pragma unroll
    for (int j = 0; j < 8; ++j) {
        unsigned r0 = rows[j].x, r1 = rows[j].y, r2 = rows[j].z, r3 = rows[j].w;
        asm volatile("" : "+v"(r0), "+v"(r1), "+v"(r2), "+v"(r3), "+v"(acc[0]));
        const float isc = 1.0f;
        acc[0] = __builtin_elementwise_fma(CVH(r0, isc, false), wv[j], acc[0]); acc[1] = __builtin_elementwise_fma(CVH(r0, isc, true), wv[j], acc[1]);
        acc[2] = __builtin_elementwise_fma(CVH(r1, isc, false), wv[j], acc[2]); acc[3] = __builtin_elementwise_fma(CVH(r1, isc, true), wv[j], acc[3]);
        acc[4] = __builtin_elementwise_fma(CVH(r2, isc, false), wv[j], acc[4]); acc[5] = __builtin_elementwise_fma(CVH(r2, isc, true), wv[j], acc[5]);
        acc[6] = __builtin_elementwise_fma(CVH(r3, isc, false), wv[j], acc[6]); acc[7] = __builtin_elementwise_fma(CVH(r3, isc, true), wv[j], acc[7]);
    }
}
__device__ __forceinline__ void p7c_vsum(Frame& F) {
    int lane_ = mk_lane(); asm volatile("" : "+v"(lane_));
    const int lane = lane_, wave = F.wave, oct = lane >> 3, li8 = lane & 7;
    const int nloc = (int)F.MISC[8], nx = (int)F.MISC[9], rank = (int)F.MISC[10], xidx = (int)F.MISC[11];
    LAS float* red = (LAS float*)F.lds + wave * 1024;
    const float* W = (const float*)(F.ws + WS_W);
    const unsigned short* EI = (const unsigned short*)(F.ws + WS_EIDX);
    for (int sl = xidx; sl < 8; sl += nx) {
    const unsigned char* VS = F.ws + WS_VS8 + (size_t)sl * 16384 * 128; const unsigned lo = (unsigned)li8 * 16u;
    int tb_ = __builtin_amdgcn_readfirstlane(rank * 8 + wave); asm volatile("" : "+s"(tb_));
    const int tb = tb_, tstep = nloc * 8, nit = (MROWS - tb + tstep - 1) / tstep;
    const unsigned char* EIb = (const unsigned char*)EI; const unsigned char* Wb = (const unsigned char*)W; unsigned char* ob = (unsigned char*)F.out;
    const unsigned ooff = (unsigned)(128 * sl + 4 * (lane & 31)) * 4u;
    const unsigned char* hb = F.ws + WS_H1B;
    VIn cur = p7c_in(EIb, Wb, hb, (unsigned)TOK(0), (unsigned)oct, ooff);
    v4u rowsA[8], rowsB[8];
    p7_rows8(VS, lo, cur.id0, rowsA);
    for (int i = 0; i < nit; ++i) {
        p7_rows8(VS, lo, cur.id1, rowsB);
        const VIn nxt = p7c_in(EIb, Wb, hb, (unsigned)TOK(i + 1), (unsigned)oct, ooff);
        h2p acch[8];
#pragma unroll
        for (int q = 0; q < 8; ++q) acch[q] = (h2p){(_Float16)0.f, (_Float16)0.f};
        __builtin_amdgcn_sched_barrier(0);
        p7c_half(rowsA, cur.wa, acch);
        __builtin_amdgcn_sched_barrier(0);
        p7_rows8(VS, lo, nxt.id0, rowsA);
        __builtin_amdgcn_sched_barrier(0);
        p7c_half(rowsB, cur.wb, acch);
        __builtin_amdgcn_sched_barrier(0);
        float acc[16];
#pragma unroll
        for (int q = 0; q < 8; ++q) { acc[2 * q] = (float)acch[q].x; acc[2 * q + 1] = (float)acch[q].y; }
        LAS f32x4* rw = (LAS f32x4*)(red + lane * 16);
        rw[0] = (f32x4){acc[0], acc[1], acc[2], acc[3]}; rw[1] = (f32x4){acc[4], acc[5], acc[6], acc[7]}; rw[2] = (f32x4){acc[8], acc[9], acc[10], acc[11]}; rw[3] = (f32x4){acc[12], acc[13], acc[14], acc[15]};
        LDS_WAIT();
        if (lane < 32) {
            const LAS f32x4* rr = (const LAS f32x4*)(red + (lane >> 2) * 16 + (lane & 3) * 4);
            f32x4 s = rr[0];
#pragma unroll
            for (int o = 1; o < 8; ++o) s += rr[o * 32];
            const f32x4 hres = {pg8::bf_lo(cur.h.x), pg8::bf_hi(cur.h.x), pg8::bf_lo(cur.h.y), pg8::bf_hi(cur.h.y)};
            *(GAS f32x4*)(ob + ((unsigned)TOK(i) * 4096u + ooff)) = hres + s * (1.0f / V_SCALE);
        }
        LDS_WAIT();
        cur = nxt;
    }
    }
}
#undef TOK

typedef long p7_i64;
#define TOK(i) min(tb + tstep * (i), MROWS - 1)
struct VIn2 { v4u id0, id1, wa, wb; v2u h; };
__device__ __forceinline__ VIn2 p7c_in2(const unsigned char* EIb, const unsigned char* wsb, const unsigned char* hb, unsigned t, unsigned g, unsigned ooff, unsigned wlane, unsigned wstride) {
    VIn2 r; const unsigned eo = t * 256u + 32u * g, wo = wlane + t * wstride;
    r.id0 = *(const GAS v4u*)(EIb + eo); r.id1 = *(const GAS v4u*)(EIb + (eo + 16u));
    r.wa = *(const GAS v4u*)(wsb + wo); r.wb = *(const GAS v4u*)(wsb + (wo + 16u));
    r.h = *(const GAS v2u*)(hb + (t * 2048u + (ooff >> 1))); return r;
}
__device__ __forceinline__ void p7c_vsum_mfma(Frame& F) {
    int lane_ = mk_lane(); asm volatile("" : "+v"(lane_));
    const int lane = lane_, wave = F.wave, oct = lane >> 3, li8 = lane & 7;
    const int nloc = (int)F.MISC[8], nx = (int)F.MISC[9], rank = (int)F.MISC[10], xidx = (int)F.MISC[11];
    LAS unsigned char* wl = F.lds + wave * 16384;
    LAS float* tro = (LAS float*)(F.lds + EPI_TAB_OFF) + wave * 128;
    const unsigned wob = (unsigned)(oct * 2048) + 16u * (unsigned)(li8 ^ (4 * ((oct >> 1) & 1)));
    const int m16 = lane & 15, kg = lane >> 4, q = m16 >> 1, pp = m16 & 1;
    const unsigned sw = (unsigned)((q >> 1) ^ (4 * (kg & 1)));
    const unsigned rb = (unsigned)(uintptr_t)(F.lds) + (unsigned)(wave * 16384 + kg * 4096 + q * 128 + 8 * pp);
    unsigned ra[8];
#pragma unroll
    for (int g = 0; g < 8; ++g) ra[g] = rb + 16u * ((unsigned)g ^ sw);
    const unsigned wlane = m16 < 2 ? (unsigned)(WS_W + m16 * 128 + kg * 32) : (unsigned)(WS_CTL + 0xC0000), wstride = m16 < 2 ? 256u : 0u;
    const unsigned short* EI = (const unsigned short*)(F.ws + WS_EIDX);
    for (int sl = xidx; sl < 8; sl += nx) {
    const unsigned char* VS = F.ws + WS_VS8 + (size_t)sl * 16384 * 128; const unsigned lo = (unsigned)li8 * 16u;
    int tb_ = __builtin_amdgcn_readfirstlane(rank * 8 + wave); asm volatile("" : "+s"(tb_));
    const int tb = tb_, tstep = nloc * 8, nit = (MROWS - tb + tstep - 1) / tstep;
    const unsigned char* EIb = (const unsigned char*)EI; const unsigned char* wsb = F.ws; unsigned char* ob = (unsigned char*)F.out;
    const unsigned ooff = (unsigned)(128 * sl + 4 * (lane & 31)) * 4u;
    const unsigned char* hb = F.ws + WS_H1B;
    VIn2 cur = p7c_in2(EIb, wsb, hb, (unsigned)TOK(0), (unsigned)oct, ooff, wlane, wstride);
    v4u rowsA[8], rowsB[8];
    p7_rows8(VS, lo, cur.id0, rowsA); p7_rows8(VS, lo, cur.id1, rowsB);
    for (int i = 0; i < nit; ++i) {
        const VIn2 nxt = p7c_in2(EIb, wsb, hb, (unsigned)TOK(i + 1), (unsigned)oct, ooff, wlane, wstride);
        f32x4 acc[8];
#pragma unroll
        for (int g = 0; g < 8; ++g) acc[g] = (f32x4){0.f, 0.f, 0.f, 0.f};
        __builtin_amdgcn_sched_barrier(0);
#define P7C_WR(R, JH) { _Pragma("unroll") for (int j = 0; j < 8; ++j) *(LAS v4u*)(wl + (JH) * 1024 + j * 128 + (wob ^ (16u * (unsigned)(j >> 1)))) = R[j]; }
#define P7C_MM(JH, A0LO, A0HI, A1LO, A1HI) { \
            p7_i64 b0_[8], b1_[8];     \
            _Pragma("unroll") for (int g = 0; g < 8; ++g) asm volatile("ds_read_b64_tr_b8 %0, %1 offset:%c2" : "=&v"(b0_[g]) : "v"(ra[g]), "i"((JH) * 1024) : "memory"); \
            _Pragma("unroll") for (int g = 0; g < 8; ++g) asm volatile("ds_read_b64_tr_b8 %0, %1 offset:%c2" : "=&v"(b1_[g]) : "v"(ra[g]), "i"((JH) * 1024 + 2048) : "memory"); \
            asm volatile("s_waitcnt lgkmcnt(0)" : "+v"(b0_[0]), "+v"(b0_[1]), "+v"(b0_[2]), "+v"(b0_[3]), "+v"(b0_[4]), "+v"(b0_[5]), "+v"(b0_[6]), "+v"(b0_[7]), "+v"(b1_[0]), "+v"(b1_[1]), "+v"(b1_[2]), "+v"(b1_[3]), "+v"(b1_[4]), "+v"(b1_[5]), "+v"(b1_[6]), "+v"(b1_[7]) :: "memory"); \
            const p7_i64 a0_ = (p7_i64)(((unsigned long)(A0HI) << 32) | (unsigned long)(A0LO)), a1_ = (p7_i64)(((unsigned long)(A1HI) << 32) | (unsigned long)(A1LO)); \
            _Pragma("unroll") for (int g = 0; g < 8; ++g) acc[g] = __builtin_amdgcn_mfma_f32_16x16x32_fp8_fp8(a0_, b0_[g], acc[g], 0, 0, 0); \
            _Pragma("unroll") for (int g = 0; g < 8; ++g) acc[g] = __builtin_amdgcn_mfma_f32_16x16x32_fp8_fp8(a1_, b1_[g], acc[g], 0, 0, 0); }
        P7C_WR(rowsA, 0)
        __builtin_amdgcn_sched_barrier(0);
        p7_rows8(VS, lo, nxt.id0, rowsA);
        __builtin_amdgcn_sched_barrier(0);
        P7C_WR(rowsB, 1)
        __builtin_amdgcn_sched_barrier(0);
        p7_rows8(VS, lo, nxt.id1, rowsB);
        __builtin_amdgcn_sched_barrier(0);
        {
            p7_i64 bq[4][8];
#pragma unroll
            for (int g = 0; g < 8; ++g) asm volatile("ds_read_b64_tr_b8 %0, %1 offset:0" : "=&v"(bq[0][g]) : "v"(ra[g]) : "memory");
#pragma unroll
            for (int g = 0; g < 8; ++g) asm volatile("ds_read_b64_tr_b8 %0, %1 offset:1024" : "=&v"(bq[1][g]) : "v"(ra[g]) : "memory");
#pragma unroll
            for (int g = 0; g < 8; ++g) asm volatile("ds_read_b64_tr_b8 %0, %1 offset:2048" : "=&v"(bq[2][g]) : "v"(ra[g]) : "memory");
#pragma unroll
            for (int g = 0; g < 8; ++g) asm volatile("ds_read_b64_tr_b8 %0, %1 offset:3072" : "=&v"(bq[3][g]) : "v"(ra[g]) : "memory");
            asm volatile("s_waitcnt lgkmcnt(0)" ::: "memory");
#pragma unroll
            for (int kq = 0; kq < 4; ++kq)
#pragma unroll
                for (int g = 0; g < 8; ++g) asm volatile("" : "+v"(bq[kq][g]));
            typedef int p7_v8i __attribute__((ext_vector_type(8)));
            const p7_v8i a8 = {(int)cur.wa.x, (int)cur.wa.y, (int)cur.wa.z, (int)cur.wa.w, (int)cur.wb.x, (int)cur.wb.y, (int)cur.wb.z, (int)cur.wb.w};
#pragma unroll
            for (int g = 0; g < 8; ++g) {
                const p7_v8i b8 = {(int)(unsigned)bq[0][g], (int)(unsigned)((unsigned long)bq[0][g] >> 32), (int)(unsigned)bq[1][g], (int)(unsigned)((unsigned long)bq[1][g] >> 32),
                                   (int)(unsigned)bq[2][g], (int)(unsigned)((unsigned long)bq[2][g] >> 32), (int)(unsigned)bq[3][g], (int)(unsigned)((unsigned long)bq[3][g] >> 32)};
                acc[g] = __builtin_amdgcn_mfma_scale_f32_16x16x128_f8f6f4(a8, b8, acc[g], 0, 0, 0, 0x7f7f7f7f, 0, 0x7f7f7f7f);
            }
        }
#undef P7C_WR
#undef P7C_MM
#define P7C_HALF
#undef P7C_HALF
        __builtin_amdgcn_sched_barrier(0);
        LAS float* tr_ = tro + (i & 1) * 1024;
        if (lane < 16) {
#pragma unroll
            for (int g = 0; g < 8; ++g) tr_[16 * g + lane] = acc[g].x + acc[g].y * (1.0f / 16.0f);
        }
        LDS_WAIT();
        if (lane < 32) {
            const f32x4 s = *(const LAS f32x4*)(tr_ + 4 * lane);
            const f32x4 hres = {pg8::bf_lo(cur.h.x), pg8::bf_hi(cur.h.x), pg8::bf_lo(cur.h.y), pg8::bf_hi(cur.h.y)};
            *(GAS f32x4*)(ob + ((unsigned)TOK(i) * 4096u + ooff)) = hres + s * (1.0f / (V_SCALE * W8_SCALE));
        }
        cur = nxt;
    }
    }
}


struct Args { const float* in[20]; float* out; unsigned char* ws; int ph_lo, ph_hi, li, dup; };
__global__ void __launch_bounds__(NWAVES * 64, 2) mk_fwd(Args args) {
    extern __shared__ __attribute__((aligned(16))) unsigned char lds[];
    Frame F;
    F.lds = (LAS unsigned char*)lds;
    F.MISC = (volatile LAS unsigned*)(F.lds + MISC_OFF);
    F.tid = threadIdx.x; F.lane = F.tid & 63; F.wave = __builtin_amdgcn_readfirstlane(F.tid >> 6);
    F.G = gridDim.x; { const int bx = blockIdx.x; F.vcu = (F.G % 8 == 0) ? (bx % 8) * (F.G / 8) + bx / 8 : bx; }
    unsigned char* ws = args.ws; F.ws = ws;
    F.ctl = (gu32*)(ws + WS_CTL);
    F.x = args.in[0]; F.meta = args.in[1]; F.gmix = args.in[2]; F.win = args.in[3]; F.bgate = args.in[4]; F.bforget = args.in[5]; F.dqg = args.in[6]; F.dkg = args.in[7]; F.dlam = args.in[8]; F.dsg = args.in[9];
    F.fqg = args.in[10]; F.fkg = args.in[11]; F.wbd = args.in[12]; F.wbf = args.in[13]; F.wout = args.in[14]; F.gffn = args.in[15]; F.wq = args.in[16]; F.sk = args.in[17]; F.u = args.in[18]; F.v = args.in[19];
    F.out = args.out;
    for (int u = F.tid; u < (LDS_BYTES - LDSCTL_OFF) / 4; u += NWAVES * 64) ((LAS unsigned*)(F.lds + LDSCTL_OFF))[u] = 0u;
    __syncthreads();
    XcdBarrier bar = xcd_barrier_post((unsigned*)(F.ctl + CW_BAR) + args.li * XCD_BAR_WORDS, F.MISC + 8); bar.wv = F.wave;
    const int lo = args.ph_lo, hi = args.ph_hi;
#define IN(k) (lo <= (k) && (k) < hi)
#define BOTH(k) (IN(k) && IN((k) + 1))
#define GRID_BAR() xcd_barrier(bar)
#define REP(k, ...) do { __VA_ARGS__; if constexpr (((DUPMASK) >> (k)) & 1) { asm volatile("" ::: "memory"); __VA_ARGS__; } } while (0)

    if (IN(0)) { REP(0, p0_prologue(F)); if (BOTH(0)) GRID_BAR(); }

    if (IN(1)) {
        if (F.vcu < 128) p1_cumscan(F, F.vcu);
        pg8::Gemm g{(const bf16*)(ws + WS_XB), (const bf16*)(ws + WS_WIN), MROWS, 5120, 512}; pg8::StaticOrder S; S.init(MROWS, 5120, F.G, (int)blockIdx.x);
        LAS float* etab = (LAS float*)(F.lds + EPI_TAB_OFF);
        for (int i = F.wave * 64 + mk_lane(); i < 2304; i += NWAVES * 64) etab[i] = i < 256 ? ((const float*)(ws + WS_GAINS))[i] : F.bgate[i - 256];
        __syncthreads();
        pg8::EpiProj E{ws, etab, etab + 256, 1.0f / (SC_X * SC_W)};
        REP(1, pg8::gemm_phase<pg8::EpiProj, pg8::StaticOrder, true, true, true>(F.wave, F.lds + RING_OFF, g, S, E));
        if (BOTH(1)) GRID_BAR();
    }
    if (IN(2)) { REP(2, p2_attention(F, (char*)lds + RING_OFF)); if (BOTH(2)) GRID_BAR(); }
    if (IN(4)) {
        int k3 = 256; asm volatile("" : "+s"(k3));
        pg8::Gemm g{(const bf16*)(ws + WS_YA), (const bf16*)(ws + WS_WBD), MROWS, 1024, k3, (const bf16*)(ws + WS_OF), (const bf16*)(ws + WS_WBF)};
        pg8::PairOrder S; S.b.init(MROWS, 1024, F.G, (int)blockIdx.x);
        pg8::EpiGatePair E{ws};
        REP(4, pg8::gemm_phase<pg8::EpiGatePair, pg8::PairOrder, true, true, true>(F.wave, F.lds + RING_OFF, g, S, E));
        if (BOTH(5)) GRID_BAR();
    }
    if (IN(6)) {
        pg8::Gemm g{(const bf16*)(ws + WS_MERGED), (const bf16*)(ws + WS_WOUT), MROWS, 1024, 512}; pg8::StaticOrder S; S.init(MROWS, 1024, F.G, (int)blockIdx.x);
#ifdef HYB_H1F
        pg8::EpiMix E{F.x, (float*)(ws + WS_GA), (bf16*)(ws + WS_H1B), (float*)(ws + WS_SSQP), 1.0f / (SC_M * SC_W)};
#else
        pg8::EpiMix E{F.x, nullptr, (bf16*)(ws + WS_H1B), (float*)(ws + WS_SSQP), 1.0f / (SC_M * SC_W)};
#endif
        REP(6, pg8::gemm_phase<pg8::EpiMix, pg8::StaticOrder, true, true, true>(F.wave, F.lds + RING_OFF, g, S, E));
        if (BOTH(6)) GRID_BAR();
    }
    if (IN(7)) {
        pg8::Gemm g{(const bf16*)(ws + WS_H1B), (const bf16*)(ws + WS_WQ), MROWS, 2048, 1024}; pg8::StaticOrder S; S.init(MROWS, 2048, F.G, (int)blockIdx.x);
        pg8::EpiQ2 E{(bf16*)(ws + WS_Q2), 1.0f};
        REP(7, pg8::gemm_phase<pg8::EpiQ2, pg8::StaticOrder, true, true, false>(F.wave, F.lds + RING_OFF, g, S, E));
        if (BOTH(7)) GRID_BAR();
    }
        if (IN(8)) { REP(8, p6_topk(F)); if (BOTH(8)) GRID_BAR(); }
    if (IN(9)) { REP(9, p7a_udot2(F)); if (BOTH(9)) GRID_BAR(); }
    if (IN(10)) { REP(10, p7b_weights(F)); if (BOTH(10)) GRID_BAR(); }
    if (IN(11)) { p7c_vsum_mfma(F); }

#undef IN
#undef BOTH
}
static int g_grid = 0;
static void mk_setup() {
    if (g_grid) return;
    int dev = 0, cus = 0;
    (void)hipGetDevice(&dev); (void)hipDeviceGetAttribute(&cus, hipDeviceAttributeMultiprocessorCount, dev);
    (void)hipFuncSetAttribute((const void*)mk_fwd, hipFuncAttributeMaxDynamicSharedMemorySize, LDS_BYTES);
    int per_cu = 0; (void)hipOccupancyMaxActiveBlocksPerMultiprocessor(&per_cu, (const void*)mk_fwd, NWAVES * 64, LDS_BYTES); (void)hipGetLastError();
    if (per_cu < 1) fprintf(stderr, "mk_fwd: occupancy query says %d blocks/CU\n", per_cu);
    if (cus != 256) fprintf(stderr, "mk_fwd: built for a 256-CU MI355X (found %d CUs); the work partition assumes 256 resident workgroups\n", cus);
    g_grid = 256;
}
extern "C" void kernel_launch(void* const* d_in, const int* in_sizes, int n_in, void* d_out, int out_size, void* d_ws, size_t ws_size, hipStream_t stream) {
    mk_setup();
    (void)hipMemsetAsync((char*)d_ws + WS_CTL, 0, CTL_ZERO_BYTES, stream);
    Args a{};
    for (int i = 0; i < 20; ++i) a.in[i] = (const float*)d_in[i];
    a.out = (float*)d_out; a.ws = (unsigned char*)d_ws; a.ph_lo = 0; a.ph_hi = N_PHASES; a.li = 0; a.dup = DUPMASK;
    hipLaunchKernelGGL(mk_fwd, dim3(g_grid), dim3(NWAVES * 64), LDS_BYTES, stream, a);
}
```
